# Optimizing an MI355X kernel written in HIP

```python
import math
import jax, jax.numpy as jnp
from jax import lax
import numpy as np

D_MODEL = 2048
BATCH = 4
SEQ = 8192
DEPTH = 1
DEC_BATCH = 32
DEC_SEQ = 64
PAST_LEN = 2048

CHUNK = 64
D_ATTN = D_MODEL // 2
D_HG = D_MODEL - D_ATTN
HEAD_DIM = 128
N_HEADS = D_ATTN // HEAD_DIM
N_KV = 2
GROUP = N_HEADS // N_KV
WINDOW = 128
N_WIN_CHUNKS = WINDOW // CHUNK
NUM_BUCKETS = 32
MAX_DISTANCE = 128
HG_DK = 128
HG_DV = 128
HG_HEADS = D_HG // HG_DV
HG_BLOCK = 16
D_FF = 5632
PLE_DIM = 256
EPS = 1e-6
NEG_INF = -1e30
IN_SPLITS = (D_ATTN, N_KV * HEAD_DIM, N_KV * HEAD_DIM, HG_HEADS * HG_DK, HG_HEADS * HG_DK, HG_HEADS * HG_DV, HG_HEADS * HG_DV)
D_IN = sum(IN_SPLITS)
IN_OFFSETS = tuple(int(o) for o in np.cumsum(IN_SPLITS)[:-1])

kernel_name = 'hybrid_swa_hgrn2_streaming_step'


def rms_norm(x, gain):
    xf = x.astype(jnp.float32)
    y = xf * lax.rsqrt(jnp.mean(xf * xf, axis=-1, keepdims=True) + EPS)
    return (y * gain.astype(jnp.float32)).astype(x.dtype)


def swiglu_half_step(x, pre, post, w_gate, w_up, w_down):
    h = rms_norm(x, pre)
    y = (jax.nn.silu(h @ w_gate) * (h @ w_up)) @ w_down
    return x + 0.5 * rms_norm(y, post)


def t5_bucket(rel):
    half = NUM_BUCKETS // 2
    max_exact = half // 2
    n = jnp.abs(rel)
    nf = jnp.maximum(n, 1).astype(jnp.float32)
    large = max_exact + (jnp.log(nf / max_exact) / math.log(MAX_DISTANCE / max_exact) * (half - max_exact)).astype(jnp.int32)
    large = jnp.minimum(large, half - 1)
    return jnp.where(rel > 0, half, 0) + jnp.where(n < max_exact, n, large)


def rel_bias(table, n_q, n_k, offset):
    rel = jnp.arange(n_k)[None, :] - offset - jnp.arange(n_q)[:, None]
    return jnp.transpose(table[t5_bucket(rel)], (2, 0, 1)).astype(jnp.float32)


def attend(q, k, v, bias, sinks, key_mask=None):
    b, n, lq = q.shape[:3]
    lk = k.shape[2]
    qg = q.reshape(b, n, lq, N_KV, GROUP, HEAD_DIM)
    s = jnp.einsum('bnqkgd,bnskd->bnkgqs', qg, k).astype(jnp.float32) * (HEAD_DIM ** -0.5)
    s = s + bias.reshape(N_KV, GROUP, lq, lk)
    if key_mask is not None:
        s = jnp.where(key_mask[None, :, None, None, None, :], s, NEG_INF)
    sink = sinks.astype(jnp.float32).reshape(N_KV, GROUP, 1, 1)
    m = jnp.maximum(jnp.max(s, axis=-1, keepdims=True), sink)
    e = jnp.exp(s - m)
    p = e / (jnp.sum(e, axis=-1, keepdims=True) + jnp.exp(sink - m))
    o = jnp.einsum('bnkgqs,bnskd->bnqkgd', p.astype(v.dtype), v)
    return o.reshape(b, n, lq, N_HEADS * HEAD_DIM)


def swa_prompt(q, k, v, table, sinks):
    b, t = q.shape[:2]
    nc = t // CHUNK
    lk = (N_WIN_CHUNKS + 1) * CHUNK
    qb = q.reshape(b, nc, CHUNK, N_HEADS, HEAD_DIM)

    def band(a):
        ap = jnp.pad(a, ((0, 0), (WINDOW, 0), (0, 0), (0, 0))).reshape(b, nc + N_WIN_CHUNKS, CHUNK, N_KV, HEAD_DIM)
        return jnp.concatenate([ap[:, j:j + nc] for j in range(N_WIN_CHUNKS + 1)], axis=2)

    key_pos = jnp.arange(nc)[:, None] * CHUNK - WINDOW + jnp.arange(lk)[None, :]
    o = attend(qb, band(k), band(v), rel_bias(table, CHUNK, lk, WINDOW), sinks, key_pos >= 0)
    return o.reshape(b, t, N_HEADS * HEAD_DIM)


def swa_sample(q, k, v, k_cache, v_cache, table, sinks):
    b, t = q.shape[:2]
    wc = k_cache.shape[1]
    k_all = jnp.concatenate([k_cache.astype(k.dtype), k], axis=1)
    v_all = jnp.concatenate([v_cache.astype(v.dtype), v], axis=1)
    o = attend(q[:, None], k_all[:, None], v_all[:, None], rel_bias(table, t, wc + t, wc), sinks)
    return o.reshape(b, t, N_HEADS * HEAD_DIM), k_all[:, t:], v_all[:, t:]


def hgrn2_mixer(q, f_logit, i, g, lb, norm_gain, s0):
    b, t = q.shape[:2]
    f32 = jnp.float32
    lbf = lb.astype(f32)
    f = lbf + (1.0 - lbf) * jax.nn.sigmoid(f_logit.astype(f32))
    n_blk = -(-t // HG_BLOCK)
    pad = n_blk * HG_BLOCK - t

    def blocks(a, d):
        a = jnp.pad(a.astype(f32), ((0, 0), (0, pad), (0, 0))).reshape(b, n_blk, HG_BLOCK, HG_HEADS, d)
        return jnp.transpose(a, (1, 0, 3, 2, 4))

    qb = blocks(q, HG_DK)
    log_f = blocks(jnp.log(f), HG_DK)
    kb = blocks(1.0 - f, HG_DK)
    ib = blocks(i, HG_DV)
    cum = jnp.cumsum(log_f, axis=3)
    q_dec = qb * jnp.exp(cum)
    k_inv = kb * jnp.exp(-cum)
    k_end = kb * jnp.exp(cum[:, :, :, -1:, :] - cum)
    blk_decay = jnp.exp(cum[:, :, :, -1, :])
    causal = jnp.tril(jnp.ones((HG_BLOCK, HG_BLOCK), dtype=bool))
    a = jnp.where(causal, jnp.einsum('nbhtk,nbhsk->nbhts', q_dec, k_inv), 0.0)
    intra = jnp.einsum('nbhts,nbhsv->nbhtv', a, ib)

    def step(state, xs):
        q_d, k_e, iv, dec = xs
        out = jnp.einsum('bhtk,bhkv->bhtv', q_d, state)
        state = dec[..., None] * state + jnp.einsum('bhtk,bhtv->bhkv', k_e, iv)
        return state, out

    s_final, inter = lax.scan(step, s0.astype(f32), (q_dec, k_end, ib, blk_decay))
    o = jnp.transpose(intra + inter, (1, 0, 3, 2, 4)).reshape(b, n_blk * HG_BLOCK, HG_HEADS, HG_DV)[:, :t]
    o = rms_norm(o, norm_gain) * jax.nn.silu(g.astype(f32).reshape(b, t, HG_HEADS, HG_DV))
    return o.reshape(b, t, D_HG).astype(q.dtype), s_final.astype(s0.dtype)


def trunk_layer(x, p, lb, lp, table, s0, kv_cache):
    x = swiglu_half_step(x, lp['ffn1_pre'], lp['ffn1_post'], lp['ffn1_w_gate'], lp['ffn1_w_up'], lp['ffn1_w_down'])
    b, t = x.shape[:2]
    z = rms_norm(x, lp['mix_pre']) @ lp['w_in']
    qa, ka, va, qh, fh, ih, gh = jnp.split(z, IN_OFFSETS, axis=-1)
    qa = qa.reshape(b, t, N_HEADS, HEAD_DIM)
    ka = ka.reshape(b, t, N_KV, HEAD_DIM)
    va = va.reshape(b, t, N_KV, HEAD_DIM)
    if kv_cache is None:
        attn = swa_prompt(qa, ka, va, table, lp['attn_sinks'])
        keep = min(WINDOW, t)
        k_new, v_new = ka[:, t - keep:], va[:, t - keep:]
    else:
        attn, k_new, v_new = swa_sample(qa, ka, va, kv_cache[0], kv_cache[1], table, lp['attn_sinks'])
    rec, s_new = hgrn2_mixer(qh, fh, ih, gh, lb, lp['hgrn_norm'], s0)
    mix = jnp.concatenate([attn, rec], axis=-1) @ lp['w_out']
    x = x + rms_norm(mix, lp['mix_post'])
    x = swiglu_half_step(x, lp['ffn2_pre'], lp['ffn2_post'], lp['ffn2_w_gate'], lp['ffn2_w_up'], lp['ffn2_w_down'])
    h = rms_norm(x, lp['ple_pre'])
    y = jax.nn.sigmoid(h @ lp['w_ple_gate']) * (p @ lp['w_ple_proj'])
    x = x + rms_norm(y, lp['ple_post'])
    return x, k_new, v_new, s_new


def setup_inputs(seed: int = 0) -> dict:
    key = jax.random.key(seed)
    ks = jax.random.split(key, 32)
    f32 = jnp.float32

    def nrm(k, shape, scale):
        return jax.random.normal(k, shape, f32) * scale

    def gain(k, shape):
        return 1.0 + 0.05 * jax.random.normal(k, shape, f32)

    wc = min(WINDOW, PAST_LEN)
    return {
        'x_prompt': nrm(ks[0], (BATCH, SEQ, D_MODEL), 1.0),
        'x_sample': nrm(ks[1], (DEC_BATCH, DEC_SEQ, D_MODEL), 1.0),
        'cache_attn_k': nrm(ks[2], (DEPTH, DEC_BATCH, wc, N_KV, HEAD_DIM), 1.0),
        'cache_attn_v': nrm(ks[3], (DEPTH, DEC_BATCH, wc, N_KV, HEAD_DIM), 1.0),
        'state_hgrn': nrm(ks[4], (DEPTH, DEC_BATCH, HG_HEADS, HG_DK, HG_DV), 0.1),
        'p_prompt': nrm(ks[5], (DEPTH, BATCH, SEQ, PLE_DIM), 1.0),
        'p_sample': nrm(ks[6], (DEPTH, DEC_BATCH, DEC_SEQ, PLE_DIM), 1.0),
        'rel_bias_table': nrm(ks[7], (NUM_BUCKETS, N_HEADS), 0.5),
        'ffn1_pre': gain(ks[8], (DEPTH, D_MODEL)),
        'ffn1_post': gain(ks[9], (DEPTH, D_MODEL)),
        'ffn1_w_gate': nrm(ks[10], (DEPTH, D_MODEL, D_FF), D_MODEL ** -0.5),
        'ffn1_w_up': nrm(ks[11], (DEPTH, D_MODEL, D_FF), D_MODEL ** -0.5),
        'ffn1_w_down': nrm(ks[12], (DEPTH, D_FF, D_MODEL), D_FF ** -0.5),
        'mix_pre': gain(ks[13], (DEPTH, D_MODEL)),
        'mix_post': gain(ks[14], (DEPTH, D_MODEL)),
        'w_in': nrm(ks[15], (DEPTH, D_MODEL, D_IN), D_MODEL ** -0.5),
        'w_out': nrm(ks[16], (DEPTH, D_MODEL, D_MODEL), D_MODEL ** -0.5),
        'attn_sinks': nrm(ks[17], (DEPTH, N_HEADS), 0.5),
        'hgrn_lb_logits': nrm(ks[18], (DEPTH + 1, D_HG), 0.5),
        'hgrn_norm': gain(ks[19], (DEPTH, HG_DV)),
        'ffn2_pre': gain(ks[20], (DEPTH, D_MODEL)),
        'ffn2_post': gain(ks[21], (DEPTH, D_MODEL)),
        'ffn2_w_gate': nrm(ks[22], (DEPTH, D_MODEL, D_FF), D_MODEL ** -0.5),
        'ffn2_w_up': nrm(ks[23], (DEPTH, D_MODEL, D_FF), D_MODEL ** -0.5),
        'ffn2_w_down': nrm(ks[24], (DEPTH, D_FF, D_MODEL), D_FF ** -0.5),
        'ple_pre': gain(ks[25], (DEPTH, D_MODEL)),
        'ple_post': gain(ks[26], (DEPTH, D_MODEL)),
        'w_ple_gate': nrm(ks[27], (DEPTH, D_MODEL, D_MODEL), D_MODEL ** -0.5),
        'w_ple_proj': nrm(ks[28], (DEPTH, PLE_DIM, D_MODEL), PLE_DIM ** -0.5),
    }


def reference(x_prompt, x_sample, cache_attn_k, cache_attn_v, state_hgrn, p_prompt, p_sample,
              rel_bias_table, ffn1_pre, ffn1_post, ffn1_w_gate, ffn1_w_up, ffn1_w_down,
              mix_pre, mix_post, w_in, w_out, attn_sinks, hgrn_lb_logits, hgrn_norm,
              ffn2_pre, ffn2_post, ffn2_w_gate, ffn2_w_up, ffn2_w_down,
              ple_pre, ple_post, w_ple_gate, w_ple_proj):
    lower_bounds = jnp.cumsum(jax.nn.softmax(hgrn_lb_logits.astype(jnp.float32), axis=0), axis=0)
    yp, ys = x_prompt, x_sample
    kp_l, vp_l, sp_l, ks_l, vs_l, ss_l = [], [], [], [], [], []
    for l in range(DEPTH):
        lp = {
            'ffn1_pre': ffn1_pre[l], 'ffn1_post': ffn1_post[l], 'ffn1_w_gate': ffn1_w_gate[l],
            'ffn1_w_up': ffn1_w_up[l], 'ffn1_w_down': ffn1_w_down[l],
            'mix_pre': mix_pre[l], 'mix_post': mix_post[l], 'w_in': w_in[l], 'w_out': w_out[l],
            'attn_sinks': attn_sinks[l], 'hgrn_norm': hgrn_norm[l],
            'ffn2_pre': ffn2_pre[l], 'ffn2_post': ffn2_post[l], 'ffn2_w_gate': ffn2_w_gate[l],
            'ffn2_w_up': ffn2_w_up[l], 'ffn2_w_down': ffn2_w_down[l],
            'ple_pre': ple_pre[l], 'ple_post': ple_post[l], 'w_ple_gate': w_ple_gate[l], 'w_ple_proj': w_ple_proj[l],
        }
        s0_prompt = jnp.zeros((yp.shape[0], HG_HEADS, HG_DK, HG_DV), state_hgrn.dtype)
        yp, kp, vp, sp = trunk_layer(yp, p_prompt[l], lower_bounds[l], lp, rel_bias_table, s0_prompt, None)
        ys, kn, vn, sn = trunk_layer(ys, p_sample[l], lower_bounds[l], lp, rel_bias_table, state_hgrn[l],
                                     (cache_attn_k[l], cache_attn_v[l]))
        kp_l.append(kp); vp_l.append(vp); sp_l.append(sp)
        ks_l.append(kn); vs_l.append(vn); ss_l.append(sn)
    return (yp, ys, jnp.stack(kp_l), jnp.stack(vp_l), jnp.stack(sp_l), jnp.stack(ks_l), jnp.stack(vs_l), jnp.stack(ss_l))
```

```cpp
#include <hip/hip_runtime.h>
#include <hip/hip_cooperative_groups.h>
#include <cstdio>
#include <cstdint>
namespace cg = cooperative_groups;
namespace pg8 {
#define PG8_LAS __attribute__((address_space(3)))
typedef unsigned short bf16_t;
typedef short bf16x8 __attribute__((ext_vector_type(8)));
typedef float f32x4 __attribute__((ext_vector_type(4)));
typedef unsigned u32x4 __attribute__((ext_vector_type(4)));
constexpr int BM = 256, BK = 64, HALF = 128, HTB = HALF * BK * 2  , STAGE_BYTES = 8 * HTB, NXCD = 8, WGM = 8;

__host__ __device__ __forceinline__ int lds_byte(int r, int c) { const int st = (r >> 4) * 2 + (c >> 5), rr = r & 15, cc = c & 31, ob = rr * 64 + cc * 2; return st * 1024 + (ob ^ (((ob >> 9) & 1) << 5)); }
__host__ __device__ __forceinline__ void stage_rc(int b, int& R, int& C) { const int st = b / 1024, sb = b % 1024, swz = sb ^ (((sb >> 9) & 1) << 5); R = (st >> 1) * 16 + swz / 64; C = (st & 1) * 32 + (swz % 64) / 2; }
__host__ __device__ __forceinline__ int perm32(int rho) { const int n = rho >> 4, i = rho & 15; return 8 * (i >> 2) + 4 * n + (i & 3); }

struct Unit { int pm, pn; };
struct Gemm { const bf16_t* A; const bf16_t* Bt; int M, N, K; int ld = 0; };

struct StaticOrder {
    int nM, nN, nwg, G, c;
    __host__ __device__ void init(int M, int N, int G_, int c_) { nM = M / BM; nN = N / BM; nwg = nM * nN; G = G_; c = c_; }
    __host__ __device__ bool next(int i, Unit& u) const {
        const long L = (long)i * G + c; if (L >= nwg) return false;
        int wgid = (int)L; { const int q = nwg / NXCD, r = nwg % NXCD, xcd = wgid % NXCD, off = wgid / NXCD; wgid = (xcd < r ? xcd * (q + 1) : r * (q + 1) + (xcd - r) * q) + off; }
        const int nig = WGM * nN, gid = wgid / nig, fm = gid * WGM, gsz = (nM - fm) < WGM ? (nM - fm) : WGM;
        u.pm = fm + ((wgid % nig) % gsz); u.pn = (wgid % nig) / gsz; return true;
    }
    __device__ __forceinline__ void a_ready(const Unit&) const {}
    __device__ __forceinline__ void done(const Unit&) const {}
};

template <int I0, int I1> struct RangeOrder : StaticOrder {
    __host__ __device__ bool next(int i, Unit& u) const { return (i + I0 < I1) && StaticOrder::next(i + I0, u); }
};
typedef __bf16 bf16x2_cv __attribute__((ext_vector_type(2)));
typedef float f32x2_cv __attribute__((ext_vector_type(2)));
__device__ __forceinline__ unsigned cvt_pk_bf16(float lo, float hi) { const f32x2_cv v = {lo, hi}; return __builtin_bit_cast(unsigned, __builtin_convertvector(v, bf16x2_cv)); }
__device__ __forceinline__ float bf_lo(unsigned u) { return __uint_as_float(u << 16); }
__device__ __forceinline__ float bf_hi(unsigned u) { return __uint_as_float(u & 0xffff0000u); }
__device__ __forceinline__ float sigmoidf_(float x) { return __builtin_amdgcn_rcpf(1.0f + __expf(-x)); }
__device__ __forceinline__ float siluf_(float x) { return x * sigmoidf_(x); }

struct EpiBf16 {
    static constexpr bool PERM = true, AFTER_DRAIN = false;
    bf16_t* O; int ldc; bool nt = false;
    __device__ __forceinline__ void operator()(const f32x4 (&acc)[2][2][4][2], const Unit& u, int wr, int wc, int fr, int fq) const {
        const int row0 = u.pm * BM + wr * 64 + fr, col0 = u.pn * BM + wc * 32 + 8 * fq;
#pragma unroll
        for (int ai = 0; ai < 2; ++ai)
#pragma unroll
            for (int m = 0; m < 4; ++m) { bf16_t* rowp = O + (size_t)(row0 + ai * HALF + m * 16) * ldc + col0;
#pragma unroll
                for (int bj = 0; bj < 2; ++bj) { const f32x4 v0 = acc[ai][bj][m][0], v1 = acc[ai][bj][m][1];
                    u32x4 w; w.x = cvt_pk_bf16(v0[0], v0[1]); w.y = cvt_pk_bf16(v0[2], v0[3]); w.z = cvt_pk_bf16(v1[0], v1[1]); w.w = cvt_pk_bf16(v1[2], v1[3]);
                    if (nt) __builtin_nontemporal_store(w, (u32x4*)(rowp + bj * HALF)); else *(u32x4*)(rowp + bj * HALF) = w; } }
    }
};
struct EpiF32Tile {
    static constexpr bool PERM = true, AFTER_DRAIN = false;
    float* P;
    __device__ __forceinline__ void operator()(const f32x4 (&acc)[2][2][4][2], const Unit&, int wr, int wc, int fr, int fq) const {
        const int row0 = wr * 64 + fr, col0 = wc * 32 + 8 * fq;
#pragma unroll
        for (int ai = 0; ai < 2; ++ai)
#pragma unroll
            for (int m = 0; m < 4; ++m) { float* rowp = P + (size_t)(row0 + ai * HALF + m * 16) * 256 + col0;
#pragma unroll
                for (int bj = 0; bj < 2; ++bj) { *(f32x4*)(rowp + bj * HALF) = acc[ai][bj][m][0]; *(f32x4*)(rowp + bj * HALF + 4) = acc[ai][bj][m][1]; } }
    }
};
struct EpiSwiGLU {
    static constexpr bool PERM = true, AFTER_DRAIN = false;
    bf16_t* O; int ldc;
    __device__ __forceinline__ void operator()(const f32x4 (&acc)[2][2][4][2], const Unit& u, int wr, int wc, int fr, int fq) const {
        const int row0 = u.pm * BM + wr * 64 + fr, col0 = u.pn * HALF + wc * 32 + 8 * fq;
#pragma unroll
        for (int ai = 0; ai < 2; ++ai)
#pragma unroll
            for (int m = 0; m < 4; ++m) { bf16_t* rowp = O + (size_t)(row0 + ai * HALF + m * 16) * ldc + col0;
                const f32x4 g0 = acc[ai][0][m][0], g1 = acc[ai][0][m][1], u0 = acc[ai][1][m][0], u1 = acc[ai][1][m][1];
                u32x4 w; w.x = cvt_pk_bf16(siluf_(g0[0]) * u0[0], siluf_(g0[1]) * u0[1]); w.y = cvt_pk_bf16(siluf_(g0[2]) * u0[2], siluf_(g0[3]) * u0[3]);
                w.z = cvt_pk_bf16(siluf_(g1[0]) * u1[0], siluf_(g1[1]) * u1[1]); w.w = cvt_pk_bf16(siluf_(g1[2]) * u1[2], siluf_(g1[3]) * u1[3]);
                __builtin_nontemporal_store(w, (u32x4*)rowp); }
    }
};
struct EpiSigMul {
    static constexpr bool PERM = true, AFTER_DRAIN = false;
    bf16_t* O; const bf16_t* U; int ldc;
    __device__ __forceinline__ void operator()(const f32x4 (&acc)[2][2][4][2], const Unit& u, int wr, int wc, int fr, int fq) const {
        const int row0 = u.pm * BM + wr * 64 + fr, col0 = u.pn * BM + wc * 32 + 8 * fq;
#pragma unroll
        for (int ai = 0; ai < 2; ++ai)
#pragma unroll
            for (int m = 0; m < 4; ++m) { const size_t off = (size_t)(row0 + ai * HALF + m * 16) * ldc + col0;
#pragma unroll
                for (int bj = 0; bj < 2; ++bj) { const f32x4 v0 = acc[ai][bj][m][0], v1 = acc[ai][bj][m][1];
                    const u32x4 uu = *(const u32x4*)(U + off + bj * HALF);
                    u32x4 w; w.x = cvt_pk_bf16(sigmoidf_(v0[0]) * bf_lo(uu.x), sigmoidf_(v0[1]) * bf_hi(uu.x)); w.y = cvt_pk_bf16(sigmoidf_(v0[2]) * bf_lo(uu.y), sigmoidf_(v0[3]) * bf_hi(uu.y));
                    w.z = cvt_pk_bf16(sigmoidf_(v1[0]) * bf_lo(uu.z), sigmoidf_(v1[1]) * bf_hi(uu.z)); w.w = cvt_pk_bf16(sigmoidf_(v1[2]) * bf_lo(uu.w), sigmoidf_(v1[3]) * bf_hi(uu.w));
                    *(u32x4*)(O + off + bj * HALF) = w; } }
    }
};
template <class Epi, class Sched, bool ALIGN_EPI = false, bool SP2 = false>
__device__ __forceinline__ void gemm_phase(PG8_LAS unsigned char* lds, const Gemm g, const Sched& S, const Epi& E) {
    const int tid = threadIdx.x, wid = __builtin_amdgcn_readfirstlane(tid >> 6), lane = tid & 63, wr = wid >> 2, wc = wid & 3, fr = lane & 15, fq = lane >> 4;
    const int K = g.K, nt = K / BK, LD = g.ld ? g.ld : g.K;
    unsigned voffA[2], voffB[2];
#pragma unroll
    for (int i = 0; i < 2; ++i) { int R, C; stage_rc(tid * 16 + i * 8192, R, C); const int Rb = Epi::PERM ? ((R & ~31) + perm32(R & 31)) : R;
        voffA[i] = (unsigned)(R * LD + C) * 2u; voffB[i] = (unsigned)(Rb * LD + C) * 2u; }
    const size_t kstep = (size_t)(BK * 2);
    const size_t hstep = (size_t)HALF * LD * 2;
    const size_t tstep = 2 * hstep;
    const unsigned ldsw = (unsigned)wid * 1024u;
    const int aoff = lds_byte(wr * 64 + fr, fq * 8), boff = lds_byte(wc * 32 + fr, fq * 8);
#define PG8_SA(b, h) (((b) * 2 + (h)) * HTB)
#define PG8_SB(b, h) ((4 + (b) * 2 + (h)) * HTB)
#define PG8_STAGE(bufoff, gbase, voff) do { _Pragma("unroll") for (int _i = 0; _i < 2; ++_i) \
        __builtin_amdgcn_global_load_lds((const unsigned*)((const char*)(gbase) + (voff)[_i]), (PG8_LAS unsigned*)(lds + (bufoff) + ldsw + _i * 8192), 16, 0, 0); } while (0)
#define PG8_LDA(dst, b, h) do { _Pragma("unroll") for (int m = 0; m < 4; ++m) _Pragma("unroll") for (int k = 0; k < 2; ++k) dst[m][k] = *(const PG8_LAS bf16x8*)(lds + PG8_SA(b, h) + aoff + m * 2048 + k * 1024); } while (0)
#define PG8_LDB(dst, b, h) do { _Pragma("unroll") for (int n = 0; n < 2; ++n) _Pragma("unroll") for (int k = 0; k < 2; ++k) dst[n][k] = *(const PG8_LAS bf16x8*)(lds + PG8_SB(b, h) + boff + n * 2048 + k * 1024); } while (0)
#define PG8_MMA(ai, bj, At, Bt) do { __builtin_amdgcn_s_setprio(1); _Pragma("unroll") for (int m = 0; m < 4; ++m) _Pragma("unroll") for (int n = 0; n < 2; ++n) _Pragma("unroll") for (int k = 0; k < 2; ++k) \
        acc[ai][bj][m][n] = __builtin_amdgcn_mfma_f32_16x16x32_bf16(Bt[n][k], At[m][k], acc[ai][bj][m][n], 0, 0, 0); __builtin_amdgcn_s_setprio(0); } while (0)
#define PG8_WAIT_V(n) asm volatile("s_waitcnt vmcnt(" #n ")" ::: "memory")
#define PG8_WAIT_L(n) asm volatile("s_waitcnt lgkmcnt(" #n ")" ::: "memory")
#define PG8_BAR __builtin_amdgcn_s_barrier()
#define PG8_SCHED __builtin_amdgcn_sched_barrier(0)
    Unit cur, nxt; int ui = 0;
    if (!S.next(0, cur)) return;
    f32x4 acc[2][2][4][2];
#pragma unroll
    for (int a = 0; a < 2; ++a)
#pragma unroll
        for (int b = 0; b < 2; ++b)
#pragma unroll
            for (int m = 0; m < 4; ++m)
#pragma unroll
                for (int n = 0; n < 2; ++n) acc[a][b][m][n] = (f32x4){0.f, 0.f, 0.f, 0.f};
    bf16x8 At[4][2], B0[2][2], B1[2][2];
    const char* cA = (const char*)g.A + (size_t)cur.pm * tstep; const char* cB = (const char*)g.Bt + (size_t)cur.pn * tstep;
    S.a_ready(cur);
    if constexpr (SP2) {
        PG8_STAGE(PG8_SB(0, 0), cB, voffB); PG8_STAGE(PG8_SB(0, 1), cB + hstep, voffB); PG8_STAGE(PG8_SA(0, 0), cA, voffA); PG8_STAGE(PG8_SA(0, 1), cA + hstep, voffA);
        if (wr == 1) PG8_BAR;
        PG8_WAIT_V(2); PG8_BAR;
        PG8_STAGE(PG8_SB(1, 0), cB + kstep, voffB); PG8_STAGE(PG8_SA(1, 0), cA + kstep, voffA); PG8_STAGE(PG8_SB(1, 1), cB + hstep + kstep, voffB);
        PG8_WAIT_V(6); PG8_BAR;
    } else {
        PG8_STAGE(PG8_SB(0, 0), cB, voffB); PG8_STAGE(PG8_SA(0, 0), cA, voffA); PG8_STAGE(PG8_SB(0, 1), cB + hstep, voffB); PG8_STAGE(PG8_SA(0, 1), cA + hstep, voffA);
        if (wr == 1) PG8_BAR;
        PG8_WAIT_V(4); PG8_BAR;
        PG8_STAGE(PG8_SB(1, 0), cB + kstep, voffB); PG8_STAGE(PG8_SA(1, 0), cA + kstep, voffA); PG8_STAGE(PG8_SB(1, 1), cB + hstep + kstep, voffB);
        PG8_WAIT_V(6); PG8_BAR;
    }
    for (;;) {
        const bool has_next = S.next(ui + 1, nxt);
        const char* nA = has_next ? (const char*)g.A + (size_t)nxt.pm * tstep : cA; const char* nB = has_next ? (const char*)g.Bt + (size_t)nxt.pn * tstep : cB;
        for (int t = 0; t < nt; t += 2) {
            const bool last = (t == nt - 2);
            const char* a1 = cA + (size_t)(t + 1) * kstep;
            const char* a2 = last ? nA : cA + (size_t)(t + 2) * kstep; const char* b2 = last ? nB : cB + (size_t)(t + 2) * kstep;
            const char* a3 = a2 + kstep; const char* b3 = b2 + kstep;
            if (last && has_next) S.a_ready(nxt);
            if constexpr (SP2) {
            PG8_LDB(B0, 0, 0); PG8_LDB(B1, 0, 1); PG8_SCHED; PG8_LDA(At, 0, 0); PG8_STAGE(PG8_SA(1, 1), a1 + hstep, voffA);
            PG8_WAIT_V(8); PG8_WAIT_L(0); PG8_BAR; PG8_MMA(0, 0, At, B0); PG8_MMA(0, 1, At, B1); PG8_BAR; PG8_SCHED;
            PG8_LDA(At, 0, 1); PG8_STAGE(PG8_SB(0, 0), b2, voffB); PG8_STAGE(PG8_SB(0, 1), b2 + hstep, voffB); PG8_STAGE(PG8_SA(0, 0), a2, voffA);
            PG8_WAIT_V(8); PG8_WAIT_L(0); PG8_BAR; PG8_MMA(1, 0, At, B0); PG8_MMA(1, 1, At, B1); PG8_BAR; PG8_SCHED;
            PG8_LDB(B0, 1, 0); PG8_LDB(B1, 1, 1); PG8_SCHED; PG8_LDA(At, 1, 0); PG8_STAGE(PG8_SA(0, 1), a2 + hstep, voffA);
            PG8_WAIT_V(8); PG8_WAIT_L(0); PG8_BAR; PG8_MMA(0, 0, At, B0); PG8_MMA(0, 1, At, B1); PG8_BAR; PG8_SCHED;
            PG8_LDA(At, 1, 1); PG8_STAGE(PG8_SB(1, 0), b3, voffB); PG8_STAGE(PG8_SB(1, 1), b3 + hstep, voffB); PG8_STAGE(PG8_SA(1, 0), a3, voffA);
            PG8_WAIT_V(8); PG8_WAIT_L(0); PG8_BAR; PG8_MMA(1, 0, At, B0); PG8_MMA(1, 1, At, B1); PG8_BAR; PG8_SCHED;
            } else {
            PG8_LDB(B0, 0, 0); PG8_SCHED; PG8_LDA(At, 0, 0); PG8_STAGE(PG8_SA(1, 1), a1 + hstep, voffA);
            PG8_WAIT_L(8); PG8_BAR; PG8_WAIT_L(0); PG8_MMA(0, 0, At, B0); PG8_BAR; PG8_SCHED;
            PG8_LDB(B1, 0, 1); PG8_STAGE(PG8_SB(0, 0), b2, voffB);
            PG8_BAR; PG8_WAIT_L(0); PG8_MMA(0, 1, At, B1); PG8_BAR;
            PG8_LDA(At, 0, 1); PG8_STAGE(PG8_SA(0, 0), a2, voffA);
            PG8_BAR; PG8_WAIT_L(0); PG8_MMA(1, 0, At, B0); PG8_BAR; PG8_SCHED;
            PG8_STAGE(PG8_SB(0, 1), b2 + hstep, voffB);
            PG8_WAIT_V(6); PG8_BAR; PG8_MMA(1, 1, At, B1); PG8_BAR;
            PG8_LDB(B0, 1, 0); PG8_SCHED; PG8_LDA(At, 1, 0); PG8_STAGE(PG8_SA(0, 1), a2 + hstep, voffA);
            PG8_WAIT_L(8); PG8_BAR; PG8_WAIT_L(0); PG8_MMA(0, 0, At, B0); PG8_BAR; PG8_SCHED;
            PG8_LDB(B1, 1, 1); PG8_STAGE(PG8_SB(1, 0), b3, voffB);
            PG8_BAR; PG8_WAIT_L(0); PG8_MMA(0, 1, At, B1); PG8_BAR;
            PG8_LDA(At, 1, 1); PG8_STAGE(PG8_SA(1, 0), a3, voffA);
            PG8_BAR; PG8_WAIT_L(0); PG8_MMA(1, 0, At, B0); PG8_BAR; PG8_SCHED;
            PG8_STAGE(PG8_SB(1, 1), b3 + hstep, voffB);
            PG8_WAIT_V(6); PG8_BAR; PG8_MMA(1, 1, At, B1); PG8_BAR;
            }
        }
        if constexpr (ALIGN_EPI) { if (wr == 0) PG8_BAR; }
        if constexpr (!Epi::AFTER_DRAIN) { E(acc, cur, wr, wc, fr, fq); S.done(cur); }
        if (!has_next) break;
#pragma unroll
        for (int a = 0; a < 2; ++a)
#pragma unroll
            for (int b = 0; b < 2; ++b)
#pragma unroll
                for (int m = 0; m < 4; ++m)
#pragma unroll
                    for (int n = 0; n < 2; ++n) acc[a][b][m][n] = (f32x4){0.f, 0.f, 0.f, 0.f};
        cur = nxt; cA = nA; cB = nB; ++ui;
        if constexpr (ALIGN_EPI) { if (wr == 1) PG8_BAR; }
    }
    PG8_WAIT_V(0);
    if constexpr (!ALIGN_EPI) { if (wr == 0) PG8_BAR; }
    PG8_BAR;
    if constexpr (Epi::AFTER_DRAIN) { E.fused(acc, cur, wr, wc, fr, fq, lds, wid, lane); S.done(cur); }
#undef PG8_SA
#undef PG8_SB
#undef PG8_STAGE
#undef PG8_LDA
#undef PG8_LDB
#undef PG8_MMA
#undef PG8_WAIT_V
#undef PG8_WAIT_L
#undef PG8_BAR
#undef PG8_SCHED
}
}
#define LAS __attribute__((address_space(3)))
using pg8::bf16_t; using pg8::bf16x8; using pg8::f32x4; using pg8::u32x4; using pg8::cvt_pk_bf16; using pg8::bf_lo; using pg8::bf_hi; using pg8::sigmoidf_; using pg8::siluf_;
typedef unsigned u32x2 __attribute__((ext_vector_type(2)));
constexpr int NWAVES = 8, NTHR = 512;
constexpr int MP = 32768, MS = 2048, M = MP + MS, D = 2048, FF = 5632, DIN = 5632, PLE = 256;
constexpr int ZQ = 0, ZK = 1024, ZV = 1280, ZHQ = 1536, ZHF = 2560, ZHI = 3584, ZHG = 4608;
constexpr float EPS = 1e-6f;
constexpr size_t MiB = 1u << 20;
constexpr size_t WS_CTL = 0, CTL_BYTES = 65536;
constexpr size_t WS_W1GU = 1 * MiB, WS_W1D = WS_W1GU + 44 * MiB, WS_WIN = WS_W1D + 22 * MiB, WS_WOUT = WS_WIN + 22 * MiB, WS_W2GU = WS_WOUT + 8 * MiB, WS_W2D = WS_W2GU + 44 * MiB,
                 WS_WPG = WS_W2D + 22 * MiB, WS_WPP = WS_WPG + 8 * MiB, WS_BTAB = WS_WPP + 1 * MiB;
constexpr size_t WS_XN = WS_BTAB + 1 * MiB;
constexpr size_t WS_H = WS_XN + 136 * MiB;
constexpr size_t WS_Y = WS_H + 374 * MiB;
constexpr size_t REC_STRIDE = 27136, NREC = (size_t)(M / 32) * 8;
constexpr size_t WS_U = WS_Y + 136 * MiB;
constexpr size_t WS_PART = WS_U + 136 * MiB;
constexpr size_t WS_PB = 1007 * MiB;
constexpr size_t WS_END = WS_PB + 17 * MiB;
static_assert(WS_PART + 32 * MiB <= WS_PB && WS_U + 136 * MiB <= WS_PB && WS_Y + 228 * MiB <= WS_PB, "ws map 2");
static_assert(NREC * REC_STRIDE + 1024 <= 228 * MiB && WS_END <= 1024 * MiB, "ws map");
constexpr int R_QD = 0, R_KE = 8192, R_IT = 16384, R_A = 24576, R_DEC = 26624;
constexpr size_t O_KP = (size_t)M * D, O_VP = O_KP + 131072, O_SP = O_VP + 131072, O_KS = O_SP + 524288, O_VS = O_KS + 1048576, O_SS = O_VS + 1048576, O_END = O_SS + 4194304;
constexpr int LDS_BYTES = 147456;
constexpr int CW_QUEUE = 0, CW_BAR = 1024;

struct Args { const float* in[29]; float* out; unsigned char* ws; int lo, hi; };
enum { I_XP = 0, I_XS, I_CK, I_CV, I_ST, I_PP, I_PS, I_TAB, I_F1PRE, I_F1POST, I_F1G, I_F1U, I_F1D, I_MPRE, I_MPOST, I_WIN, I_WOUT, I_SINK, I_LB, I_HN, I_F2PRE, I_F2POST, I_F2G, I_F2U, I_F2D, I_PPRE, I_PPOST, I_WPG, I_WPP };

__device__ __forceinline__ float wave_sum(float v) {
#pragma unroll
    for (int o = 1; o < 64; o <<= 1) v += __shfl_xor(v, o);
    return v;
}
#define LDS_WAIT() asm volatile("s_waitcnt lgkmcnt(0)" ::: "memory")

__device__ __forceinline__ void transpose_item(const float* W, int K, int N, bf16_t* WT, int k0, int n0, int drow0, LAS float* scr, int lane) {
    asm volatile("" : "+v"(lane)); __builtin_assume(lane >= 0 && lane < 64);
#pragma unroll 8
    for (int i = 0; i < 32; ++i) { const int kk = 2 * i + (lane >> 5); scr[kk * 33 + (lane & 31)] = __builtin_nontemporal_load(&W[(size_t)(k0 + kk) * N + n0 + (lane & 31)]); }
    LDS_WAIT();
    const int c = lane & 7;
#pragma unroll
    for (int j = 0; j < 4; ++j) { const int n = (lane >> 3) + 8 * j; const LAS float* s = scr + (8 * c) * 33 + n;
        u32x4 o; o.x = cvt_pk_bf16(s[0 * 33], s[1 * 33]); o.y = cvt_pk_bf16(s[2 * 33], s[3 * 33]); o.z = cvt_pk_bf16(s[4 * 33], s[5 * 33]); o.w = cvt_pk_bf16(s[6 * 33], s[7 * 33]);
        *(u32x4*)(WT + (size_t)(drow0 + n) * K + k0 + 8 * c) = o; }
    LDS_WAIT();
}
__device__ __forceinline__ bool transpose_mat(int& r, const float* W, int K, int N, bf16_t* WT, int mode, LAS float* scr, int lane) {
    const int nblk = N / 32, items = (K / 64) * nblk;
    if (r >= items) { r -= items; return false; }
    const int kb = r / nblk, nb = r % nblk, n0 = 32 * nb;
    const int drow0 = mode == 0 ? n0 : (n0 / 128) * 256 + (n0 % 128) + (mode == 2 ? 128 : 0);
    transpose_item(W, K, N, WT, 64 * kb, n0, drow0, scr, lane);
    return true;
}
__device__ __forceinline__ void rms_row_to_bf16(const f32x4 (&v)[8], const float* gain, bf16_t* orow, int lane) {
    const f32x4* gr = (const f32x4*)gain + lane;
    float s = 0.f;
#pragma unroll
    for (int j = 0; j < 8; ++j) s += (v[j].x * v[j].x + v[j].y * v[j].y) + (v[j].z * v[j].z + v[j].w * v[j].w);
    const float rstd = rsqrtf(wave_sum(s) * (1.f / D) + EPS);
    u32x2* o8 = (u32x2*)orow + lane;
#pragma unroll
    for (int j = 0; j < 8; ++j) { const f32x4 g = gr[64 * j]; u32x2 w; w.x = cvt_pk_bf16(v[j].x * rstd * g.x, v[j].y * rstd * g.y); w.y = cvt_pk_bf16(v[j].z * rstd * g.z, v[j].w * rstd * g.w); o8[64 * j] = w; }
}
__device__ __forceinline__ void norm_load_y(const bf16_t* Y, const float* PART, int m, int lane, u32x2 (&y)[8]) {
    const u32x2* yr = (const u32x2*)(Y + (size_t)m * D) + lane;
#pragma unroll
    for (int j = 0; j < 8; ++j) y[j] = __builtin_nontemporal_load(&yr[64 * j]);
    const int pm = m >> 8, q = pm - 16;
    if (PART && q >= 0 && (q & 15) < 8) {
        const int pn = q >> 4, c = (q & 15) * 8 + pn;
        const float* pa = PART + ((size_t)(2 * c) * 256 + (m & 255)) * 256 + 4 * lane;
        const f32x4 a = *(const f32x4*)pa, b = *(const f32x4*)(pa + 65536);
        u32x2 w; w.x = cvt_pk_bf16(a.x + b.x, a.y + b.y); w.y = cvt_pk_bf16(a.z + b.z, a.w + b.w);
#pragma unroll
        for (int j = 0; j < 8; ++j) if (j == pn) y[j] = w;
    }
}
template <bool XIN_BF, bool XOUT_BF>
__device__ __forceinline__ void norm_load_x(const float* xp, const float* xs, const bf16_t* xb, int m, int lane, f32x4 (&v)[8]) {
    if (XIN_BF) { const u32x2* xr = (const u32x2*)(xb + (size_t)m * D) + lane;
#pragma unroll
        for (int j = 0; j < 8; ++j) { const u32x2 w = __builtin_nontemporal_load(&xr[64 * j]); v[j] = (f32x4){bf_lo(w.x), bf_hi(w.x), bf_lo(w.y), bf_hi(w.y)}; }
    } else { const float* xrow = (m < MP) ? xp + (size_t)m * D : xs + (size_t)(m - MP) * D; const f32x4* xr = (const f32x4*)xrow + lane;
#pragma unroll
        for (int j = 0; j < 8; ++j) v[j] = __builtin_nontemporal_load(&xr[64 * j]); }
}
template <bool XIN_BF, bool XOUT_BF>
__device__ __forceinline__ void norm_pass(const float* xp, const float* xs, const bf16_t* xbin, const bf16_t* Y, const float* post, float scale, const float* pre, float* X, bf16_t* xbout, bf16_t* XN, int gw, int NGW, int lane, const float* PART = nullptr) {
    f32x4 v[8]; u32x2 y[8];
    norm_load_x<XIN_BF, XOUT_BF>(xp, xs, xbin, gw, lane, v); norm_load_y(Y, PART, gw, lane, y);
    for (int m = gw; m < M; m += NGW) {
        f32x4 vn[8]; u32x2 yn[8];
        const int mn = m + NGW < M ? m + NGW : m;
        norm_load_x<XIN_BF, XOUT_BF>(xp, xs, xbin, mn, lane, vn); norm_load_y(Y, PART, mn, lane, yn);
        float s = 0.f;
#pragma unroll
        for (int j = 0; j < 8; ++j) { const float a = bf_lo(y[j].x), b = bf_hi(y[j].x), c = bf_lo(y[j].y), d = bf_hi(y[j].y); s += (a * a + b * b) + (c * c + d * d); }
        const float rs = rsqrtf(wave_sum(s) * (1.f / D) + EPS) * scale; float s2 = 0.f;
#pragma unroll
        for (int j = 0; j < 8; ++j) { const f32x4 g = ((const f32x4*)post + lane)[64 * j];
            v[j].x += bf_lo(y[j].x) * rs * g.x; v[j].y += bf_hi(y[j].x) * rs * g.y; v[j].z += bf_lo(y[j].y) * rs * g.z; v[j].w += bf_hi(y[j].y) * rs * g.w;
            s2 += (v[j].x * v[j].x + v[j].y * v[j].y) + (v[j].z * v[j].z + v[j].w * v[j].w);
            if (XOUT_BF) { u32x2 w; w.x = cvt_pk_bf16(v[j].x, v[j].y); w.y = cvt_pk_bf16(v[j].z, v[j].w); __builtin_nontemporal_store(w, &((u32x2*)(xbout + (size_t)m * D) + lane)[64 * j]); }
            else __builtin_nontemporal_store(v[j], &((f32x4*)(X + (size_t)m * D) + lane)[64 * j]); }
        if (pre) {
            const float r2 = rsqrtf(wave_sum(s2) * (1.f / D) + EPS); u32x2* o8 = (u32x2*)(XN + (size_t)m * D) + lane;
#pragma unroll
            for (int j = 0; j < 8; ++j) { const f32x4 g = ((const f32x4*)pre + lane)[64 * j]; u32x2 w; w.x = cvt_pk_bf16(v[j].x * r2 * g.x, v[j].y * r2 * g.y); w.y = cvt_pk_bf16(v[j].z * r2 * g.z, v[j].w * r2 * g.w); o8[64 * j] = w; }
        }
#pragma unroll
        for (int j = 0; j < 8; ++j) { v[j] = vn[j]; y[j] = yn[j]; }
    }
}
constexpr int PREP_WSTRIDE = 2 * 32 * 132 * 2;
typedef short bf16x4 __attribute__((ext_vector_type(4)));
__device__ __forceinline__ void hgrn_prep_item(const bf16_t* Z, const float* lbl, unsigned char* REC, int cidx, int h, LAS unsigned char* wl, int lane) {
    asm volatile("" : "+v"(lane)); __builtin_assume(lane >= 0 && lane < 64);
    LAS bf16_t* Xs = (LAS bf16_t*)wl; LAS bf16_t* Ys = Xs + 32 * 132;
    const int k0 = 2 * lane, m0 = cidx * 32, c16 = lane & 15, g = lane >> 4;
    float lb[2], omlb[2], cum[2] = {0.f, 0.f};
#pragma unroll
    for (int e = 0; e < 2; ++e) { const float l0 = lbl[h * 128 + k0 + e], l1 = lbl[1024 + h * 128 + k0 + e]; lb[e] = __builtin_amdgcn_rcpf(1.f + __expf(l1 - l0)); omlb[e] = 1.f - lb[e]; }
    float cv[32][2]; unsigned omp[32], qraw[32], itp[2][16];
    const bf16_t* zr = Z + (size_t)m0 * DIN + h * 128 + k0;
#pragma unroll
    for (int t = 0; t < 32; ++t) {
        const unsigned ff = *(const unsigned*)(zr + (size_t)t * DIN + ZHF), ii = *(const unsigned*)(zr + (size_t)t * DIN + ZHI);
        qraw[t] = *(const unsigned*)(zr + (size_t)t * DIN + ZHQ); float omv[2];
#pragma unroll
        for (int e = 0; e < 2; ++e) {
            const float fl = e ? bf_hi(ff) : bf_lo(ff);
            const float ex = __expf(-fl), sg = __builtin_amdgcn_rcpf(1.f + ex);
            const float f = lb[e] + omlb[e] * sg;
            omv[e] = omlb[e] * (ex * sg);
            cum[e] += __logf(f); cv[t][e] = cum[e];
        }
        omp[t] = cvt_pk_bf16(omv[0], omv[1]);
        if ((t & 1) == 0) { itp[0][t >> 1] = ii & 0xffffu; itp[1][t >> 1] = ii >> 16; }
        else { itp[0][t >> 1] |= ii << 16; itp[1][t >> 1] |= ii & 0xffff0000u; }
        if ((t & 15) == 15) asm volatile("" ::: "memory");
    }
    unsigned char* R = REC + ((size_t)cidx * 8 + h) * REC_STRIDE;
    {   u32x4* it = (u32x4*)(R + R_IT + k0 * 64);
#pragma unroll
        for (int e = 0; e < 2; ++e)
#pragma unroll
            for (int q4 = 0; q4 < 4; ++q4) it[4 * e + q4] = (u32x4){itp[e][4 * q4], itp[e][4 * q4 + 1], itp[e][4 * q4 + 2], itp[e][4 * q4 + 3]}; }
#pragma unroll
    for (int t = 0; t < 32; ++t) {
        const float q0 = bf_lo(qraw[t]), q1 = bf_hi(qraw[t]);
        *(LAS unsigned*)(Xs + t * 132 + k0) = cvt_pk_bf16(q0 * __expf(cv[t][0]), q1 * __expf(cv[t][1]));
        *(LAS unsigned*)(Ys + t * 132 + k0) = cvt_pk_bf16(bf_lo(omp[t]) * __expf(cv[15][0] - cv[t][0]), bf_hi(omp[t]) * __expf(cv[15][1] - cv[t][1]));
    }
    {
        u32x4* ke = (u32x4*)(R + R_KE + k0 * 64);
#pragma unroll
        for (int e = 0; e < 2; ++e) {
            unsigned kep[16];
#pragma unroll
            for (int t2 = 0; t2 < 16; ++t2) kep[t2] = cvt_pk_bf16((e ? bf_hi(omp[2 * t2]) : bf_lo(omp[2 * t2])) * __expf(cum[e] - cv[2 * t2][e]), (e ? bf_hi(omp[2 * t2 + 1]) : bf_lo(omp[2 * t2 + 1])) * __expf(cum[e] - cv[2 * t2 + 1][e]));
#pragma unroll
            for (int q4 = 0; q4 < 4; ++q4) { ke[4 * e + q4] = (u32x4){kep[4 * q4], kep[4 * q4 + 1], kep[4 * q4 + 2], kep[4 * q4 + 3]}; }
        }
        float2 dd; dd.x = __expf(cum[0]); dd.y = __expf(cum[1]); *(float2*)(R + R_DEC + k0 * 4) = dd;
    }
    LDS_WAIT();
#pragma unroll
    for (int tb = 0; tb < 2; ++tb)
#pragma unroll
        for (int kk = 0; kk < 4; ++kk) {
            const u32x2 lo = *(const LAS u32x2*)(Xs + (16 * tb + c16) * 132 + 32 * kk + 4 * g), hi = *(const LAS u32x2*)(Xs + (16 * tb + c16) * 132 + 32 * kk + 16 + 4 * g);
            *(u32x4*)(R + R_QD + ((tb * 4 + kk) * 64 + lane) * 16) = (u32x4){lo.x, lo.y, hi.x, hi.y};
        }
    LDS_WAIT();
#pragma unroll
    for (int t = 0; t < 32; ++t) {
        const float q0 = bf_lo(qraw[t]), q1 = bf_hi(qraw[t]);
        *(LAS unsigned*)(Xs + t * 132 + k0) = cvt_pk_bf16(q0 * __expf(cv[t][0] - cv[15][0]), q1 * __expf(cv[t][1] - cv[15][1]));
    }
    LDS_WAIT();
    f32x4 a00 = {0.f, 0.f, 0.f, 0.f}, a10 = a00, a11 = a00;
#pragma unroll
    for (int kk = 0; kk < 4; ++kk) {
        bf16x8 qf[2], kf[2];
#pragma unroll
        for (int b = 0; b < 2; ++b) {
            const u32x2 qlo = *(const LAS u32x2*)(Xs + (16 * b + c16) * 132 + 32 * kk + 4 * g), qhi = *(const LAS u32x2*)(Xs + (16 * b + c16) * 132 + 32 * kk + 16 + 4 * g);
            const u32x2 klo = *(const LAS u32x2*)(Ys + (16 * b + c16) * 132 + 32 * kk + 4 * g), khi = *(const LAS u32x2*)(Ys + (16 * b + c16) * 132 + 32 * kk + 16 + 4 * g);
            qf[b] = __builtin_bit_cast(bf16x8, ((u32x4){qlo.x, qlo.y, qhi.x, qhi.y})); kf[b] = __builtin_bit_cast(bf16x8, ((u32x4){klo.x, klo.y, khi.x, khi.y}));
        }
        a00 = __builtin_amdgcn_mfma_f32_16x16x32_bf16(kf[0], qf[0], a00, 0, 0, 0);
        a10 = __builtin_amdgcn_mfma_f32_16x16x32_bf16(kf[0], qf[1], a10, 0, 0, 0);
        a11 = __builtin_amdgcn_mfma_f32_16x16x32_bf16(kf[1], qf[1], a11, 0, 0, 0);
    }
#pragma unroll
    for (int i = 0; i < 4; ++i) if (4 * g + i > c16) { a00[i] = 0.f; a11[i] = 0.f; }
    u32x2 w;
    w.x = cvt_pk_bf16(a00[0], a00[1]); w.y = cvt_pk_bf16(a00[2], a00[3]); *(u32x2*)(R + R_A + (c16 * 32 + 4 * g) * 2) = w;
    w.x = 0u; w.y = 0u; *(u32x2*)(R + R_A + (c16 * 32 + 16 + 4 * g) * 2) = w;
    w.x = cvt_pk_bf16(a10[0], a10[1]); w.y = cvt_pk_bf16(a10[2], a10[3]); *(u32x2*)(R + R_A + ((16 + c16) * 32 + 4 * g) * 2) = w;
    w.x = cvt_pk_bf16(a11[0], a11[1]); w.y = cvt_pk_bf16(a11[2], a11[3]); *(u32x2*)(R + R_A + ((16 + c16) * 32 + 16 + 4 * g) * 2) = w;
    LDS_WAIT();
}

constexpr int CH_NS = 4, CH_SLOT = 27648;
static_assert(CH_NS * CH_SLOT + 32768 <= 147392, "chain LDS: ring + state-copy exchange");
#define CH_RAWBAR() do { asm volatile("s_waitcnt lgkmcnt(0)" ::: "memory"); __builtin_amdgcn_s_barrier(); asm volatile("" ::: "memory"); } while (0)
__device__ __forceinline__ void ch_issue(const unsigned char* Rl, LAS unsigned char* dst, int wave) {
    __builtin_amdgcn_global_load_lds((const unsigned*)(Rl + wave * 1024), (LAS unsigned*)(dst + wave * 1024), 16, 0, 0);
    __builtin_amdgcn_global_load_lds((const unsigned*)(Rl + (wave + 8) * 1024), (LAS unsigned*)(dst + (wave + 8) * 1024), 16, 0, 0);
    __builtin_amdgcn_global_load_lds((const unsigned*)(Rl + (wave + 16) * 1024), (LAS unsigned*)(dst + (wave + 16) * 1024), 16, 0, 0);
    if (wave < 3) __builtin_amdgcn_global_load_lds((const unsigned*)(Rl + (wave + 24) * 1024), (LAS unsigned*)(dst + (wave + 24) * 1024), 16, 0, 0);
}
#define CH_WAITN(N) asm volatile("s_waitcnt vmcnt(%0)" :: "n"(N) : "memory")
#define CH_WAIT(EX) do { if (wave < 3) CH_WAITN(8); else if (wave < 4) CH_WAITN(6); else CH_WAITN(6 + (EX)); } while (0)
__device__ __forceinline__ void ch_out(const bf16x8 (&QDf)[2][4], const bf16x8 (&Af)[2], const bf16x8& ITo, const LAS unsigned char* sbp, bf16_t* mrow, int lane) {
    bf16x8 Sb[4];
#pragma unroll
    for (int kk = 0; kk < 4; ++kk) Sb[kk] = *(const LAS bf16x8*)(sbp + kk * 1024 + lane * 16);
    f32x4 o0 = {0.f, 0.f, 0.f, 0.f}, o1 = o0;
    o0 = __builtin_amdgcn_mfma_f32_16x16x32_bf16(ITo, Af[0], o0, 0, 0, 0);
    o1 = __builtin_amdgcn_mfma_f32_16x16x32_bf16(ITo, Af[1], o1, 0, 0, 0);
#pragma unroll
    for (int kk = 0; kk < 4; ++kk) { o0 = __builtin_amdgcn_mfma_f32_16x16x32_bf16(Sb[kk], QDf[0][kk], o0, 0, 0, 0); o1 = __builtin_amdgcn_mfma_f32_16x16x32_bf16(Sb[kk], QDf[1][kk], o1, 0, 0, 0); }
    u32x2 w; w.x = cvt_pk_bf16(o0[0], o0[1]); w.y = cvt_pk_bf16(o0[2], o0[3]);
    *(u32x2*)mrow = w;
    w.x = cvt_pk_bf16(o1[0], o1[1]); w.y = cvt_pk_bf16(o1[2], o1[3]);
    *(u32x2*)(mrow + (size_t)16 * D) = w;
}
__device__ __forceinline__ void hgrn_chain(const unsigned char* REC, const float* s0, float* sout, bf16_t* MIX,
                                           int cidx0, int nchunks, int h, int vhalf, LAS unsigned char* lds, int wave, int lane) {
    asm volatile("" : "+v"(lane)); __builtin_assume(lane >= 0 && lane < 64);
    const int c16 = lane & 15, g = lane >> 4, p = wave & 3, v0 = 64 * vhalf + 16 * p;
    const bool stw = wave < 4;
    LAS unsigned char* SB = lds + CH_NS * CH_SLOT;
    f32x4 S[8];
#pragma unroll
    for (int kb = 0; kb < 8; ++kb)
#pragma unroll
        for (int i = 0; i < 4; ++i) S[kb][i] = (s0 && stw) ? s0[(size_t)(16 * kb + 4 * g + i) * 128 + v0 + c16] : 0.f;
    bf16_t* mo = MIX + (size_t)(cidx0 * 32 + c16) * D + 1024 + h * 128 + v0 + 4 * g;
    const unsigned char* Rl = REC + ((size_t)cidx0 * 8 + h) * REC_STRIDE + lane * 16;
    const unsigned char* Rlast = Rl + (size_t)(nchunks - 1) * 8 * REC_STRIDE;
    asm volatile("s_waitcnt vmcnt(0)" ::: "memory");
    const unsigned char* Ri = Rl;
#pragma unroll
    for (int cc = 0; cc < CH_NS - 1; ++cc) { ch_issue(Ri, lds + cc * CH_SLOT, wave); Ri = Ri < Rlast ? Ri + 8 * REC_STRIDE : Rlast; }
    CH_WAIT(0);
    CH_RAWBAR();
    int slot = 0, islot = CH_NS - 1;
    bf16x8 QDf[2][4], Af[2], ITo;
    for (int c = 0; c < nchunks; ++c) {
        ch_issue(Ri, lds + islot * CH_SLOT, wave); Ri = Ri < Rlast ? Ri + 8 * REC_STRIDE : Rlast;
        islot = islot == CH_NS - 1 ? 0 : islot + 1;
        const LAS unsigned char* R = lds + slot * CH_SLOT;
        slot = slot == CH_NS - 1 ? 0 : slot + 1;
        if (stw) {
            bf16x8 KEf[8], ITf; f32x4 DEC[8];
#pragma unroll
            for (int kb = 0; kb < 8; ++kb) { DEC[kb] = *(const LAS f32x4*)(R + R_DEC + (16 * kb + 4 * g) * 4); KEf[kb] = *(const LAS bf16x8*)(R + R_KE + ((16 * kb + c16) * 32 + 8 * g) * 2); }
            ITf = *(const LAS bf16x8*)(R + R_IT + ((v0 + c16) * 32 + 8 * g) * 2);
            LAS unsigned char* sbp = SB + ((c & 1) * 4 + p) * 4096 + lane * 16;
#pragma unroll
            for (int kk = 0; kk < 4; ++kk) {
                u32x4 sb; sb.x = cvt_pk_bf16(S[2 * kk][0], S[2 * kk][1]); sb.y = cvt_pk_bf16(S[2 * kk][2], S[2 * kk][3]);
                sb.z = cvt_pk_bf16(S[2 * kk + 1][0], S[2 * kk + 1][1]); sb.w = cvt_pk_bf16(S[2 * kk + 1][2], S[2 * kk + 1][3]);
                *(LAS u32x4*)(sbp + kk * 1024) = sb;
            }
#pragma unroll
            for (int kb = 0; kb < 8; ++kb) S[kb] = __builtin_amdgcn_mfma_f32_16x16x32_bf16(KEf[kb], ITf, S[kb] * DEC[kb], 0, 0, 0);
        } else {
            if (c > 0) ch_out(QDf, Af, ITo, SB + (((c - 1) & 1) * 4 + p) * 4096, mo + (size_t)(c - 1) * 32 * D, lane);
            ITo = *(const LAS bf16x8*)(R + R_IT + ((v0 + c16) * 32 + 8 * g) * 2);
#pragma unroll
            for (int tb = 0; tb < 2; ++tb) {
                Af[tb] = *(const LAS bf16x8*)(R + R_A + ((16 * tb + c16) * 32 + 8 * g) * 2);
#pragma unroll
                for (int kk = 0; kk < 4; ++kk) QDf[tb][kk] = *(const LAS bf16x8*)(R + R_QD + ((tb * 4 + kk) * 64 + lane) * 16);
            }
        }
        if (c == 0) CH_WAIT(0); else if (c == 1) CH_WAIT(2); else if (c == 2) CH_WAIT(4); else CH_WAIT(6);
        CH_RAWBAR();
    }
    if (!stw) ch_out(QDf, Af, ITo, SB + (((nchunks - 1) & 1) * 4 + p) * 4096, mo + (size_t)(nchunks - 1) * 32 * D, lane);
    if (stw) {
#pragma unroll
        for (int kb = 0; kb < 8; ++kb)
#pragma unroll
            for (int i = 0; i < 4; ++i) sout[(size_t)(16 * kb + 4 * g + i) * 128 + v0 + c16] = S[kb][i];
    }
    asm volatile("s_waitcnt vmcnt(0)" ::: "memory");
    CH_RAWBAR();
}
__device__ __forceinline__ void rec_norm_pass(const bf16_t* Z, const float* gain, bf16_t* MIX, int gw, int NGW, int lane) {
    const int part = lane & 15;
    const f32x4 g0 = *(const f32x4*)(gain + 8 * part), g1 = *(const f32x4*)(gain + 8 * part + 4);
    const int p0 = gw * 4 + (lane >> 4), NP = M * 8, step = NGW * 4;
    u32x4 ov, gv;
    { const int m = p0 >> 3, h = p0 & 7; ov = *(const u32x4*)(MIX + (size_t)m * D + 1024 + h * 128 + 8 * part); gv = __builtin_nontemporal_load((const u32x4*)(Z + (size_t)m * DIN + ZHG + h * 128 + 8 * part)); }
    for (int p = p0; p < NP; p += step) {
        const int m = p >> 3, h = p & 7, pn = p + step < NP ? p + step : p, mn = pn >> 3, hn = pn & 7;
        bf16_t* op = MIX + (size_t)m * D + 1024 + h * 128 + 8 * part;
        const u32x4 ovn = *(const u32x4*)(MIX + (size_t)mn * D + 1024 + hn * 128 + 8 * part), gvn = __builtin_nontemporal_load((const u32x4*)(Z + (size_t)mn * DIN + ZHG + hn * 128 + 8 * part));
        float x[8] = {bf_lo(ov.x), bf_hi(ov.x), bf_lo(ov.y), bf_hi(ov.y), bf_lo(ov.z), bf_hi(ov.z), bf_lo(ov.w), bf_hi(ov.w)};
        float s = 0.f;
#pragma unroll
        for (int j = 0; j < 8; ++j) s += x[j] * x[j];
        s += __shfl_xor(s, 1); s += __shfl_xor(s, 2); s += __shfl_xor(s, 4); s += __shfl_xor(s, 8);
        const float rs = rsqrtf(s * (1.f / 128.f) + EPS);
        u32x4 w;
        w.x = cvt_pk_bf16(x[0] * rs * g0.x * siluf_(bf_lo(gv.x)), x[1] * rs * g0.y * siluf_(bf_hi(gv.x)));
        w.y = cvt_pk_bf16(x[2] * rs * g0.z * siluf_(bf_lo(gv.y)), x[3] * rs * g0.w * siluf_(bf_hi(gv.y)));
        w.z = cvt_pk_bf16(x[4] * rs * g1.x * siluf_(bf_lo(gv.z)), x[5] * rs * g1.y * siluf_(bf_hi(gv.z)));
        w.w = cvt_pk_bf16(x[6] * rs * g1.z * siluf_(bf_lo(gv.w)), x[7] * rs * g1.w * siluf_(bf_hi(gv.w)));
        *(u32x4*)op = w;
        ov = ovn; gv = gvn;
    }
}
constexpr int KS_STRIDE = 136, VT_STRIDE = 196;
constexpr int ATT_KS = 0, ATT_VT = 192 * KS_STRIDE * 2, ATT_BT = ATT_VT + 128 * VT_STRIDE * 2, ATT_END = ATT_BT + 4 * 256 * 4;
static_assert(ATT_END <= 131072, "attention LDS");
__device__ __forceinline__ void attn_item(const bf16_t* Z, const float* ck, const float* cv, const float* btab, const float* sinks, bf16_t* MIX, int item, LAS unsigned char* lds, int tid, int wave, int lane) {
    asm volatile("" : "+v"(tid), "+v"(lane)); __builtin_assume(lane >= 0 && lane < 64 && tid >= 0 && tid < 512);
    LAS bf16_t* Ks = (LAS bf16_t*)(lds + ATT_KS); LAS bf16_t* VTs = (LAS bf16_t*)(lds + ATT_VT); LAS float* bts = (LAS float*)(lds + ATT_BT);
    const bool prompt = item < 1024;
    int kvh, qrow0, krow0, kmin, sidx = 0;
    if (prompt) { const int b = item >> 8, c = (item >> 1) & 127; kvh = item & 1; qrow0 = b * 8192 + c * 64; krow0 = qrow0 - 128; kmin = c == 0 ? 128 : (c == 1 ? 64 : 0); }
    else { sidx = (item - 1024) >> 1; kvh = item & 1; qrow0 = MP + sidx * 64; krow0 = qrow0 - 128; kmin = 0; }
#pragma unroll 2
    for (int it = 0; it < 6; ++it) {
        const int task = tid + NTHR * it, kq = task & 3, key = (task >> 2) % 192, ch = (task / 768) * 4 + kq;
        u32x4 kv4 = {0u, 0u, 0u, 0u}, vv4 = {0u, 0u, 0u, 0u};
        if (!prompt && key < 128) {
            const float* kp = ck + ((size_t)(sidx * 128 + key) * 2 + kvh) * 128 + ch * 8; const float* vp = cv + ((size_t)(sidx * 128 + key) * 2 + kvh) * 128 + ch * 8;
            const f32x4 a = *(const f32x4*)kp, b = *(const f32x4*)(kp + 4), c = *(const f32x4*)vp, d = *(const f32x4*)(vp + 4);
            kv4 = (u32x4){cvt_pk_bf16(a.x, a.y), cvt_pk_bf16(a.z, a.w), cvt_pk_bf16(b.x, b.y), cvt_pk_bf16(b.z, b.w)};
            vv4 = (u32x4){cvt_pk_bf16(c.x, c.y), cvt_pk_bf16(c.z, c.w), cvt_pk_bf16(d.x, d.y), cvt_pk_bf16(d.z, d.w)};
        } else if (key >= kmin) {
            const bf16_t* zp = Z + (size_t)(krow0 + key) * DIN + ZK + kvh * 128 + ch * 8;
            kv4 = *(const u32x4*)zp; vv4 = *(const u32x4*)(zp + 256);
        }
        *(LAS u32x4*)(Ks + key * KS_STRIDE + ch * 8) = kv4;
        LAS bf16_t* vt = VTs + (ch * 8) * VT_STRIDE + key;
        vt[0 * VT_STRIDE] = (bf16_t)(vv4.x & 0xffffu); vt[1 * VT_STRIDE] = (bf16_t)(vv4.x >> 16); vt[2 * VT_STRIDE] = (bf16_t)(vv4.y & 0xffffu); vt[3 * VT_STRIDE] = (bf16_t)(vv4.y >> 16);
        vt[4 * VT_STRIDE] = (bf16_t)(vv4.z & 0xffffu); vt[5 * VT_STRIDE] = (bf16_t)(vv4.z >> 16); vt[6 * VT_STRIDE] = (bf16_t)(vv4.w & 0xffffu); vt[7 * VT_STRIDE] = (bf16_t)(vv4.w >> 16);
    }
    for (int i = tid; i < 1024; i += NTHR) bts[i] = btab[(kvh * 4 + (i >> 8)) * 256 + (i & 255)];
    const int c16 = lane & 15, g = lane >> 4, gh = wave >> 1, qhalf = wave & 1, hq = kvh * 4 + gh;
    bf16x8 Qf[2][4];
#pragma unroll
    for (int nb = 0; nb < 2; ++nb)
#pragma unroll
        for (int kk = 0; kk < 4; ++kk) Qf[nb][kk] = *(const bf16x8*)(Z + (size_t)(qrow0 + qhalf * 32 + nb * 16 + c16) * DIN + ZQ + hq * 128 + 32 * kk + 8 * g);
    const float sink = sinks[hq];
    __syncthreads();
    f32x4 sacc[12][2];
#pragma unroll
    for (int mb = 0; mb < 12; ++mb) { sacc[mb][0] = (f32x4){0.f, 0.f, 0.f, 0.f}; sacc[mb][1] = (f32x4){0.f, 0.f, 0.f, 0.f};
#pragma unroll
        for (int kk = 0; kk < 4; ++kk) { const bf16x8 Kf = *(const LAS bf16x8*)(Ks + (16 * mb + c16) * KS_STRIDE + 32 * kk + 8 * g);
            sacc[mb][0] = __builtin_amdgcn_mfma_f32_16x16x32_bf16(Kf, Qf[0][kk], sacc[mb][0], 0, 0, 0);
            sacc[mb][1] = __builtin_amdgcn_mfma_f32_16x16x32_bf16(Kf, Qf[1][kk], sacc[mb][1], 0, 0, 0); } }
    float inv[2];
    const float scale = 0.08838834764831845f;
#pragma unroll
    for (int nb = 0; nb < 2; ++nb) {
        const int qidx = qhalf * 32 + nb * 16 + c16; float mx = -3.0e38f;
#pragma unroll
        for (int mb = 0; mb < 12; ++mb)
#pragma unroll
            for (int i = 0; i < 4; ++i) { const int kidx = 16 * mb + 4 * g + i; float s = sacc[mb][nb][i] * scale + bts[gh * 256 + kidx - qidx + 63]; s = kidx < kmin ? -1e30f : s; sacc[mb][nb][i] = s; mx = fmaxf(mx, s); }
        mx = fmaxf(mx, __shfl_xor(mx, 16)); mx = fmaxf(mx, __shfl_xor(mx, 32)); mx = fmaxf(mx, sink);
        float sum = 0.f;
#pragma unroll
        for (int mb = 0; mb < 12; ++mb)
#pragma unroll
            for (int i = 0; i < 4; ++i) { const float e = __expf(sacc[mb][nb][i] - mx); sum += e; sacc[mb][nb][i] = e; }
        sum += __shfl_xor(sum, 16); sum += __shfl_xor(sum, 32); sum += __expf(sink - mx);
        inv[nb] = 1.0f / sum;
    }
    bf16x8 Pf[2][6];
#pragma unroll
    for (int nb = 0; nb < 2; ++nb)
#pragma unroll
        for (int ks = 0; ks < 6; ++ks) { u32x4 p; p.x = cvt_pk_bf16(sacc[2 * ks][nb][0], sacc[2 * ks][nb][1]); p.y = cvt_pk_bf16(sacc[2 * ks][nb][2], sacc[2 * ks][nb][3]);
            p.z = cvt_pk_bf16(sacc[2 * ks + 1][nb][0], sacc[2 * ks + 1][nb][1]); p.w = cvt_pk_bf16(sacc[2 * ks + 1][nb][2], sacc[2 * ks + 1][nb][3]); Pf[nb][ks] = __builtin_bit_cast(bf16x8, p); }
#pragma unroll
    for (int db = 0; db < 8; ++db) {
        f32x4 o0 = {0.f, 0.f, 0.f, 0.f}, o1 = {0.f, 0.f, 0.f, 0.f};
#pragma unroll
        for (int ks = 0; ks < 6; ++ks) { const LAS bf16_t* vp = VTs + (16 * db + c16) * VT_STRIDE + 32 * ks + 4 * g; const u32x2 lo = *(const LAS u32x2*)vp, hi = *(const LAS u32x2*)(vp + 16);
            const bf16x8 Vf = __builtin_bit_cast(bf16x8, ((u32x4){lo.x, lo.y, hi.x, hi.y}));
            o0 = __builtin_amdgcn_mfma_f32_16x16x32_bf16(Vf, Pf[0][ks], o0, 0, 0, 0);
            o1 = __builtin_amdgcn_mfma_f32_16x16x32_bf16(Vf, Pf[1][ks], o1, 0, 0, 0); }
        o0 = o0 * inv[0]; o1 = o1 * inv[1];
        u32x2 w0, w1; w0.x = cvt_pk_bf16(o0[0], o0[1]); w0.y = cvt_pk_bf16(o0[2], o0[3]); w1.x = cvt_pk_bf16(o1[0], o1[1]); w1.y = cvt_pk_bf16(o1[2], o1[3]);
        *(u32x2*)(MIX + (size_t)(qrow0 + qhalf * 32 + c16) * D + hq * 128 + 16 * db + 4 * g) = w0;
        *(u32x2*)(MIX + (size_t)(qrow0 + qhalf * 32 + 16 + c16) * D + hq * 128 + 16 * db + 4 * g) = w1;
    }
    __syncthreads();
}
#define XB_TMO      128
#define XB_XCNT(j)  (256  + 64 * (j))
#define XB_XSUB(j)  (1280 + 64 * (j))
#define XB_XGEN(j)  (2304 + 64 * (j))
#define XB_TOP      3328
#define XB_TOPGEN   3392
#define XCD_BAR_WORDS 3456
#define XB_SPIN_CAP (1u << 18)

__device__ __forceinline__ unsigned xb_ld(unsigned* p)              { return __hip_atomic_load(p, __ATOMIC_RELAXED, __HIP_MEMORY_SCOPE_AGENT); }
__device__ __forceinline__ unsigned xb_add(unsigned* p, unsigned v) { return __hip_atomic_fetch_add(p, v, __ATOMIC_RELAXED, __HIP_MEMORY_SCOPE_AGENT); }
__device__ __forceinline__ unsigned xb_xcc_id() { return (unsigned)__builtin_amdgcn_s_getreg((3 << 11) | 20) & 0xFu; }
#define XB_SPIN(cond, bar) do { unsigned _sp = 0; while (cond) { __builtin_amdgcn_s_sleep(1); \
    if ((++_sp & 255u) == 0u) { if (xb_ld(&(bar)[XB_TMO])) break; if (_sp > XB_SPIN_CAP) { atomicAdd(&(bar)[XB_TMO], 1u); break; } } } } while (0)

struct XcdBarrier {
    unsigned* bar; unsigned x;
    volatile LAS unsigned* st;
};

__device__ __forceinline__ XcdBarrier xcd_barrier_post(unsigned* bar, volatile LAS unsigned* st) {
    XcdBarrier b; b.bar = bar; b.x = xb_xcc_id(); b.st = st;
    if (threadIdx.x == 0) (void)xb_add(&bar[XB_XCNT(b.x)], 1u);
    return b;
}
__device__ __forceinline__ void xcd_barrier_complete(unsigned* bar, unsigned x, unsigned& nloc, unsigned& nx) {
    const unsigned G = gridDim.x * gridDim.y * gridDim.z;
    unsigned sum, cnt, mine, sp = 0u;
    for (;;) {
        sum = 0u; cnt = 0u; mine = 0u;
#pragma unroll
        for (unsigned j = 0; j < 16; ++j) { const unsigned c = xb_ld(&bar[XB_XCNT(j)]); sum += c; cnt += (c > 0u) ? 1u : 0u; mine = (j == x) ? c : mine; }
        if (sum == G) break;
        __builtin_amdgcn_s_sleep(1);
        if ((++sp & 255u) == 0u) { if (xb_ld(&bar[XB_TMO])) break; if (sp > XB_SPIN_CAP) { atomicAdd(&bar[XB_TMO], 1u); break; } }
    }
    nloc = mine > 0u ? mine : 1u; nx = cnt > 0u ? cnt : 1u;
}

__device__ __forceinline__ void xcd_barrier(const XcdBarrier& b) {
    asm volatile("s_waitcnt vmcnt(0)" ::: "memory");
    __syncthreads();
    if (threadIdx.x == 0) {
        unsigned* bar = b.bar;
        __builtin_amdgcn_s_waitcnt(0);
        unsigned nloc = b.st[0], nx = b.st[1];
        if (nloc == 0u) { xcd_barrier_complete(bar, b.x, nloc, nx); b.st[0] = nloc; b.st[1] = nx; }
        const unsigned old = xb_add(&bar[XB_XSUB(b.x)], 1u);
        const unsigned gen = old / nloc;
        if (old + 1u == (gen + 1u) * nloc) {
            __builtin_amdgcn_fence(__ATOMIC_RELEASE, "agent");
            asm volatile("s_waitcnt vmcnt(0)" ::: "memory");
            const unsigned og = xb_add(&bar[XB_TOP], 1u);
            const unsigned tg = og / nx;
            if (og + 1u == (tg + 1u) * nx) xb_add(&bar[XB_TOPGEN], 1u);
            else XB_SPIN(xb_ld(&bar[XB_TOPGEN]) == tg, bar);
            __builtin_amdgcn_fence(__ATOMIC_ACQUIRE, "agent");
            xb_add(&bar[XB_XGEN(b.x)], 1u);
            asm volatile("s_waitcnt vmcnt(0)" ::: "memory");
        } else {
            XB_SPIN(xb_ld(&bar[XB_XGEN(b.x)]) == gen, bar);
            __builtin_amdgcn_fence(__ATOMIC_ACQUIRE, "agent");
            asm volatile("s_waitcnt vmcnt(0)" ::: "memory");
        }
    }
    __syncthreads();
}

constexpr int NPHASE = 16;
__global__ void __launch_bounds__(NTHR, 2) hybrid_fwd(Args args) {
    extern __shared__ __attribute__((aligned(16))) unsigned char lds_raw[];
    LAS unsigned char* lds = (LAS unsigned char*)lds_raw;
    cg::grid_group grid = cg::this_grid();
    const int tid = threadIdx.x, lane = tid & 63, wave = __builtin_amdgcn_readfirstlane(tid >> 6);
    const int G = gridDim.x, bx = blockIdx.x;
    const int gw = bx * NWAVES + wave, NGW = G * NWAVES;
    unsigned char* ws = args.ws; float* out = args.out;
    unsigned* ctl = (unsigned*)(ws + WS_CTL);
    bf16_t* W1GU = (bf16_t*)(ws + WS_W1GU); bf16_t* W1D = (bf16_t*)(ws + WS_W1D); bf16_t* WIN = (bf16_t*)(ws + WS_WIN); bf16_t* WOUT = (bf16_t*)(ws + WS_WOUT);
    bf16_t* W2GU = (bf16_t*)(ws + WS_W2GU); bf16_t* W2D = (bf16_t*)(ws + WS_W2D); bf16_t* WPG = (bf16_t*)(ws + WS_WPG); bf16_t* WPP = (bf16_t*)(ws + WS_WPP);
    float* BTAB = (float*)(ws + WS_BTAB);
    bf16_t* XN = (bf16_t*)(ws + WS_XN); bf16_t* MIX = XN; bf16_t* H = (bf16_t*)(ws + WS_H); bf16_t* Zb = H; bf16_t* U = (bf16_t*)(ws + WS_U); bf16_t* Y = (bf16_t*)(ws + WS_Y);
    bf16_t* XB0 = (bf16_t*)out; bf16_t* XB1 = (bf16_t*)(ws + WS_H);
    float* PART = (float*)(ws + WS_PART); unsigned char* REC = ws + WS_Y; bf16_t* PB = (bf16_t*)(ws + WS_PB);
    const int lo = args.lo, hi = args.hi;
#define IN(k) (lo <= (k) && (k) < hi)
#define SEAM(k) do { if (IN(k) && IN((k) + 1)) { if ((k) == 0) grid.sync(); else xcd_barrier(xbar); } } while (0)
    {   volatile LAS unsigned* bst = (volatile LAS unsigned*)(lds + 147408);
        if (tid < 2) bst[tid] = 0u;
        __syncthreads(); }
    const XcdBarrier xbar = xcd_barrier_post(ctl + CW_BAR, (volatile LAS unsigned*)(lds + 147408));

    if (IN(0)) {
        LAS float* scr = (LAS float*)(lds + wave * 16384);
        constexpr int IT_BIG = 32 * 176;
        constexpr int NITEMS = 2 * IT_BIG;
        for (int it = gw; it < NITEMS; it += NGW) {
            int r = it;
            if (transpose_mat(r, args.in[I_F1G], D, FF, W1GU, 1, scr, lane)) continue;
            transpose_mat(r, args.in[I_F1U], D, FF, W1GU, 2, scr, lane);
        }
        f32x4 xv[8];
        { const f32x4* xr = (const f32x4*)(args.in[I_XP] + (size_t)gw * D) + lane;
#pragma unroll
          for (int j = 0; j < 8; ++j) xv[j] = __builtin_nontemporal_load(&xr[64 * j]); }
        for (int m = gw; m < M; m += NGW) {
            const int mn = m + NGW < M ? m + NGW : m;
            const float* xrow = (mn < MP) ? args.in[I_XP] + (size_t)mn * D : args.in[I_XS] + (size_t)(mn - MP) * D;
            f32x4 xn[8];
#pragma unroll
            for (int j = 0; j < 8; ++j) xn[j] = __builtin_nontemporal_load(&((const f32x4*)xrow + lane)[64 * j]);
            rms_row_to_bf16(xv, args.in[I_F1PRE], XN + (size_t)m * D, lane);
#pragma unroll
            for (int j = 0; j < 8; ++j) xv[j] = xn[j];
            const float* prow = (m < MP) ? args.in[I_PP] + (size_t)m * PLE : args.in[I_PS] + (size_t)(m - MP) * PLE;
            const f32x4 pv = __builtin_nontemporal_load(&((const f32x4*)prow)[lane]); u32x2 w; w.x = cvt_pk_bf16(pv.x, pv.y); w.y = cvt_pk_bf16(pv.z, pv.w);
            ((u32x2*)(PB + (size_t)m * PLE))[lane] = w;
        }
        if (bx == 0) {
            for (int i = tid; i < 8 * 256; i += NTHR) {
                const int h = i >> 8, idx = i & 255, rel = idx - 191, n = rel < 0 ? -rel : rel;
                const int large = 8 + (n >= 12) + (n >= 16) + (n >= 23) + (n >= 32) + (n >= 46) + (n >= 64) + (n >= 91);
                const int bucket = (rel > 0 ? 16 : 0) + (n < 8 ? n : large);
                BTAB[i] = args.in[I_TAB][bucket * 8 + h];
            }
        }
    }
    SEAM(0);
    if (IN(1)) { { pg8::Gemm g{XN, W1GU, M, 2 * FF, D}; pg8::StaticOrder S; S.init(M, 2 * FF, G, bx); pg8::EpiSwiGLU E{H, FF};
        pg8::gemm_phase<pg8::EpiSwiGLU, pg8::StaticOrder, true, true>(lds, g, S, E); }
        if (bx >= 96) { LAS float* scr = (LAS float*)(lds + wave * 16384); constexpr int IT_BIG = 32 * 176;
            for (int it = (bx - 96) * NWAVES + wave; it < 2 * IT_BIG; it += 160 * NWAVES) { int r = it;
                if (transpose_mat(r, args.in[I_F1D], FF, D, W1D, 0, scr, lane)) continue;
                transpose_mat(r, args.in[I_WIN], D, DIN, WIN, 0, scr, lane); } } }
    SEAM(1);
    if (IN(2)) {
        { pg8::Gemm g{H, W1D, M, D, FF}; pg8::RangeOrder<0, 4> S; S.init(M, D, G, bx); pg8::EpiBf16 E{Y, D};
          pg8::gemm_phase<pg8::EpiBf16, pg8::RangeOrder<0, 4>, true, true>(lds, g, S, E); }
        if (bx < 128) { const int hk = (bx & 1) * (FF / 2);
            pg8::Gemm g{H + hk, W1D + hk, M, D, FF / 2, FF}; pg8::RangeOrder<4, 5> S; S.init(M, D, G, bx >> 1); pg8::EpiF32Tile E{PART + (size_t)bx * 65536};
            pg8::gemm_phase<pg8::EpiF32Tile, pg8::RangeOrder<4, 5>, true, true>(lds, g, S, E); }
        else { LAS float* scr = (LAS float*)(lds + wave * 16384); constexpr int IT_BIG = 32 * 176;
            for (int it = (bx - 128) * NWAVES + wave; it < 2 * IT_BIG; it += 128 * NWAVES) { int r = it;
                if (transpose_mat(r, args.in[I_F2G], D, FF, W2GU, 1, scr, lane)) continue;
                transpose_mat(r, args.in[I_F2U], D, FF, W2GU, 2, scr, lane); } } }
    SEAM(2);
    if (IN(3)) norm_pass<false, true>(args.in[I_XP], args.in[I_XS], nullptr, Y, args.in[I_F1POST], 0.5f, args.in[I_MPRE], nullptr, XB0, XN, gw, NGW, lane, PART);
    SEAM(3);
    if (IN(4)) { { pg8::Gemm g{XN, WIN, M, DIN, D}; pg8::StaticOrder S; S.init(M, DIN, G, bx); pg8::EpiBf16 E{Zb, DIN, true};
        pg8::gemm_phase<pg8::EpiBf16, pg8::StaticOrder, true, true>(lds, g, S, E); }
        if (bx >= 176) { LAS float* scr = (LAS float*)(lds + wave * 16384); constexpr int IT_SQ = 32 * 64, IT_PP = 4 * 64;
            for (int it = (bx - 176) * NWAVES + wave; it < IT_SQ + IT_PP; it += 80 * NWAVES) { int r = it;
                if (transpose_mat(r, args.in[I_WOUT], D, D, WOUT, 0, scr, lane)) continue;
                transpose_mat(r, args.in[I_WPP], PLE, D, WPP, 0, scr, lane); } } }
    SEAM(4);
    if (IN(5)) {
        for (int cidx = bx; cidx < M / 32; cidx += G) hgrn_prep_item(Zb, args.in[I_LB], REC, cidx, wave, lds + wave * PREP_WSTRIDE, lane);
        const int gt = bx * NTHR + tid, NGT = G * NTHR;
        for (int idx = gt; idx < 2 * (131072 + 1048576); idx += NGT) {
            if (idx < 262144) { const int which = idx >> 17, r = idx & 131071, b = r >> 15, j = (r >> 8) & 127, c = r & 255;
                out[O_KP + idx] = __uint_as_float((unsigned)Zb[(size_t)(b * 8192 + 8064 + j) * DIN + ZK + which * 256 + c] << 16); }
            else { const int r2 = idx - 262144, which = r2 >> 20, r = r2 & 1048575, s = r >> 15, j = (r >> 8) & 127, c = r & 255;
                float v;
                if (j < 64) v = args.in[which ? I_CV : I_CK][(size_t)(s * 128 + 64 + j) * 256 + c];
                else v = __uint_as_float((unsigned)Zb[(size_t)(MP + s * 64 + j - 64) * DIN + ZK + which * 256 + c] << 16);
                out[O_KS + r2] = v; }
        }
    }
    SEAM(5);
    if (IN(6)) {
        LAS int* qslot = (LAS int*)(lds + 147392);
        constexpr int N_PCH = 64, N_ATT = 1088, N_SCH = 512, N_ALL = N_PCH + N_ATT + N_SCH;
        for (;;) {
            if (tid == 0) *qslot = (int)atomicAdd(ctl + CW_QUEUE, 1u);
            __syncthreads();
            const int it = *qslot;
            __syncthreads();
            if (it >= N_ALL) break;
            if (it < N_PCH) { const int ch = it >> 1, b = ch >> 3, h = ch & 7;
                hgrn_chain(REC, nullptr, out + O_SP + (size_t)ch * 16384, MIX, b * 256, 256, h, it & 1, lds, wave, lane); }
            else if (it < N_PCH + N_ATT) attn_item(Zb, args.in[I_CK], args.in[I_CV], BTAB, args.in[I_SINK], MIX, it - N_PCH, lds, tid, wave, lane);
            else { const int si = it - N_PCH - N_ATT, sc = si >> 1, s = sc >> 3, h = sc & 7;
                hgrn_chain(REC, args.in[I_ST] + (size_t)sc * 16384, out + O_SS + (size_t)sc * 16384, MIX, 1024 + s * 2, 2, h, si & 1, lds, wave, lane); }
        }
    }
    SEAM(6);
    if (IN(7)) rec_norm_pass(Zb, args.in[I_HN], MIX, gw, NGW, lane);
    SEAM(7);
    if (IN(8)) { { pg8::Gemm g{MIX, WOUT, M, D, D}; pg8::StaticOrder S; S.init(M, D, G, bx); pg8::EpiBf16 E{Y, D};
        pg8::gemm_phase<pg8::EpiBf16, pg8::StaticOrder, true, true>(lds, g, S, E); }
        if (G == 256 ? bx >= 64 : true) { pg8::Gemm g{PB, WPP, M, D, PLE}; pg8::StaticOrder S; if (G == 256) S.init(M, D, 192, bx - 64); else S.init(M, D, G, bx); pg8::EpiBf16 E{U, D};
            pg8::gemm_phase<pg8::EpiBf16, pg8::StaticOrder, true, true>(lds, g, S, E); } }
    SEAM(8);
    if (IN(9)) norm_pass<true, true>(nullptr, nullptr, XB0, Y, args.in[I_MPOST], 1.0f, args.in[I_F2PRE], nullptr, XB0, XN, gw, NGW, lane);
    SEAM(9);
    if (IN(10)) { { pg8::Gemm g{XN, W2GU, M, 2 * FF, D}; pg8::StaticOrder S; S.init(M, 2 * FF, G, bx); pg8::EpiSwiGLU E{H, FF};
        pg8::gemm_phase<pg8::EpiSwiGLU, pg8::StaticOrder, true, true>(lds, g, S, E); }
        if (bx >= 96) { LAS float* scr = (LAS float*)(lds + wave * 16384); constexpr int IT_BIG = 32 * 176, IT_SQ = 32 * 64;
            for (int it = (bx - 96) * NWAVES + wave; it < IT_BIG + IT_SQ; it += 160 * NWAVES) { int r = it;
                if (transpose_mat(r, args.in[I_F2D], FF, D, W2D, 0, scr, lane)) continue;
                transpose_mat(r, args.in[I_WPG], D, D, WPG, 0, scr, lane); } } }
    SEAM(10);
    if (IN(11)) {
        { pg8::Gemm g{H, W2D, M, D, FF}; pg8::RangeOrder<0, 4> S; S.init(M, D, G, bx); pg8::EpiBf16 E{Y, D};
          pg8::gemm_phase<pg8::EpiBf16, pg8::RangeOrder<0, 4>, true, true>(lds, g, S, E); }
        if (bx < 128) { const int hk = (bx & 1) * (FF / 2);
            pg8::Gemm g{H + hk, W2D + hk, M, D, FF / 2, FF}; pg8::RangeOrder<4, 5> S; S.init(M, D, G, bx >> 1); pg8::EpiF32Tile E{PART + (size_t)bx * 65536};
            pg8::gemm_phase<pg8::EpiF32Tile, pg8::RangeOrder<4, 5>, true, true>(lds, g, S, E); } }
    SEAM(11);
    if (IN(12)) norm_pass<true, true>(nullptr, nullptr, XB0, Y, args.in[I_F2POST], 0.5f, args.in[I_PPRE], nullptr, XB1, XN, gw, NGW, lane, PART);
    SEAM(12);
    if (IN(14)) { pg8::Gemm g{XN, WPG, M, D, D}; pg8::StaticOrder S; S.init(M, D, G, bx); pg8::EpiSigMul E{Y, U, D};
        pg8::gemm_phase<pg8::EpiSigMul, pg8::StaticOrder, true, true>(lds, g, S, E); }
    SEAM(14);
    if (IN(15)) norm_pass<true, false>(nullptr, nullptr, XB1, Y, args.in[I_PPOST], 1.0f, nullptr, out, nullptr, nullptr, gw, NGW, lane);
#undef IN
#undef SEAM
}

extern "C" void kernel_launch(void* const* d_in, const int* in_sizes, int n_in, void* d_out, int out_size, void* d_ws, size_t ws_size, hipStream_t stream) {
    static int grid = 0;
    if (grid == 0) {
        if (n_in != 29 || (size_t)out_size != O_END || ws_size < WS_END) { fprintf(stderr, "kernel_launch: unexpected sizes n_in %d out %d ws %zu\n", n_in, out_size, ws_size); grid = -1; return; }
        int dev = 0, cus = 0, per_cu = 0;
        hipGetDevice(&dev); hipDeviceGetAttribute(&cus, hipDeviceAttributeMultiprocessorCount, dev);
        if (hipFuncSetAttribute((const void*)hybrid_fwd, hipFuncAttributeMaxDynamicSharedMemorySize, LDS_BYTES) != hipSuccess) { fprintf(stderr, "kernel_launch: hipFuncSetAttribute failed\n"); grid = -1; return; }
        if (hipOccupancyMaxActiveBlocksPerMultiprocessor(&per_cu, (const void*)hybrid_fwd, NTHR, LDS_BYTES) != hipSuccess || per_cu < 1) per_cu = 1;
        (void)hipGetLastError();
        grid = cus * per_cu;
        if (grid != 256) { fprintf(stderr, "kernel_launch: this build needs a 256-workgroup grid (got %d)\n", grid); grid = -1; return; }
        fprintf(stderr, "kernel_launch: grid %d (cus %d x %d)\n", grid, cus, per_cu);
    }
    if (grid < 0) return;
    hipMemsetAsync((char*)d_ws + WS_CTL, 0, CTL_BYTES, stream);
    Args a{};
    for (int i = 0; i < 29; ++i) a.in[i] = (const float*)d_in[i];
    a.out = (float*)d_out; a.ws = (unsigned char*)d_ws; a.lo = 0; a.hi = NPHASE;
    void* kargs[] = {&a};
    hipError_t e = hipLaunchCooperativeKernel((const void*)hybrid_fwd, dim3(grid), dim3(NTHR), kargs, LDS_BYTES, stream);
    if (e != hipSuccess) fprintf(stderr, "kernel_launch: cooperative launch failed: %s (grid %d)\n", hipGetErrorString(e), grid);
}
```

```cpp
#include <hip/hip_runtime.h>
#include <hip/hip_cooperative_groups.h>
#include <cstdio>
#include <cstdint>
namespace cg = cooperative_groups;
namespace pg8 {
#define PG8_LAS __attribute__((address_space(3)))
typedef unsigned short bf16_t;
typedef short bf16x8 __attribute__((ext_vector_type(8)));
typedef float f32x4 __attribute__((ext_vector_type(4)));
typedef unsigned u32x4 __attribute__((ext_vector_type(4)));
constexpr int BM = 256, BK = 64, HALF = 128, HTB = HALF * BK * 2  , STAGE_BYTES = 8 * HTB, NXCD = 8, WGM = 8;

__host__ __device__ __forceinline__ int lds_byte(int r, int c) { const int st = (r >> 4) * 2 + (c >> 5), rr = r & 15, cc = c & 31, ob = rr * 64 + cc * 2; return st * 1024 + (ob ^ (((ob >> 9) & 1) << 5)); }
__host__ __device__ __forceinline__ void stage_rc(int b, int& R, int& C) { const int st = b / 1024, sb = b % 1024, swz = sb ^ (((sb >> 9) & 1) << 5); R = (st >> 1) * 16 + swz / 64; C = (st & 1) * 32 + (swz % 64) / 2; }
__host__ __device__ __forceinline__ int perm32(int rho) { const int n = rho >> 4, i = rho & 15; return 8 * (i >> 2) + 4 * n + (i & 3); }

struct Unit { int pm, pn; };
struct Gemm { const bf16_t* A; const bf16_t* Bt; int M, N, K; int ld = 0; };

struct StaticOrder {
    int nM, nN, nwg, G, c; int wgm = WGM;
    __host__ __device__ void init(int M, int N, int G_, int c_) { nM = M / BM; nN = N / BM; nwg = nM * nN; G = G_; c = c_; }
    __host__ __device__ bool next(int i, Unit& u) const {
        const long L = (long)i * G + c; if (L >= nwg) return false;
        int wgid = (int)L; { const int q = nwg / NXCD, r = nwg % NXCD, xcd = wgid % NXCD, off = wgid / NXCD; wgid = (xcd < r ? xcd * (q + 1) : r * (q + 1) + (xcd - r) * q) + off; }
        const int nig = wgm * nN, gid = wgid / nig, fm = gid * wgm, gsz = (nM - fm) < wgm ? (nM - fm) : wgm;
        u.pm = fm + ((wgid % nig) % gsz); u.pn = (wgid % nig) / gsz; return true;
    }
    __device__ __forceinline__ void a_ready(const Unit&) const {}
    __device__ __forceinline__ void done(const Unit&) const {}
};

template <int I0, int I1> struct RangeOrder : StaticOrder {
    __host__ __device__ bool next(int i, Unit& u) const { return (i + I0 < I1) && StaticOrder::next(i + I0, u); }
};
typedef __bf16 bf16x2_cv __attribute__((ext_vector_type(2)));
typedef float f32x2_cv __attribute__((ext_vector_type(2)));
__device__ __forceinline__ unsigned cvt_pk_bf16(float lo, float hi) { const f32x2_cv v = {lo, hi}; return __builtin_bit_cast(unsigned, __builtin_convertvector(v, bf16x2_cv)); }
__device__ __forceinline__ float bf_lo(unsigned u) { return __uint_as_float(u << 16); }
__device__ __forceinline__ float bf_hi(unsigned u) { return __uint_as_float(u & 0xffff0000u); }
__device__ __forceinline__ float sigmoidf_(float x) { return __builtin_amdgcn_rcpf(1.0f + __expf(-x)); }
__device__ __forceinline__ float siluf_(float x) { return x * sigmoidf_(x); }

struct EpiBf16 {
    static constexpr bool PERM = true, AFTER_DRAIN = false;
    bf16_t* O; int ldc; bool nt = false;
    __device__ __forceinline__ void operator()(const f32x4 (&acc)[2][2][4][2], const Unit& u, int wr, int wc, int fr, int fq) const {
        const int row0 = u.pm * BM + wr * 64 + fr, col0 = u.pn * BM + wc * 32 + 8 * fq;
#pragma unroll
        for (int ai = 0; ai < 2; ++ai)
#pragma unroll
            for (int m = 0; m < 4; ++m) { bf16_t* rowp = O + (size_t)(row0 + ai * HALF + m * 16) * ldc + col0;
#pragma unroll
                for (int bj = 0; bj < 2; ++bj) { const f32x4 v0 = acc[ai][bj][m][0], v1 = acc[ai][bj][m][1];
                    u32x4 w; w.x = cvt_pk_bf16(v0[0], v0[1]); w.y = cvt_pk_bf16(v0[2], v0[3]); w.z = cvt_pk_bf16(v1[0], v1[1]); w.w = cvt_pk_bf16(v1[2], v1[3]);
                    if (nt) __builtin_nontemporal_store(w, (u32x4*)(rowp + bj * HALF)); else *(u32x4*)(rowp + bj * HALF) = w; } }
    }
};
struct EpiF32Tile {
    static constexpr bool PERM = true, AFTER_DRAIN = false;
    float* P;
    __device__ __forceinline__ void operator()(const f32x4 (&acc)[2][2][4][2], const Unit&, int wr, int wc, int fr, int fq) const {
        const int row0 = wr * 64 + fr, col0 = wc * 32 + 8 * fq;
#pragma unroll
        for (int ai = 0; ai < 2; ++ai)
#pragma unroll
            for (int m = 0; m < 4; ++m) { float* rowp = P + (size_t)(row0 + ai * HALF + m * 16) * 256 + col0;
#pragma unroll
                for (int bj = 0; bj < 2; ++bj) { *(f32x4*)(rowp + bj * HALF) = acc[ai][bj][m][0]; *(f32x4*)(rowp + bj * HALF + 4) = acc[ai][bj][m][1]; } }
    }
};
struct EpiSwiGLU {
    static constexpr bool PERM = true, AFTER_DRAIN = false;
    bf16_t* O; int ldc;
    __device__ __forceinline__ void operator()(const f32x4 (&acc)[2][2][4][2], const Unit& u, int wr, int wc, int fr, int fq) const {
        const int row0 = u.pm * BM + wr * 64 + fr, col0 = u.pn * HALF + wc * 32 + 8 * fq;
#pragma unroll
        for (int ai = 0; ai < 2; ++ai)
#pragma unroll
            for (int m = 0; m < 4; ++m) { bf16_t* rowp = O + (size_t)(row0 + ai * HALF + m * 16) * ldc + col0;
                const f32x4 g0 = acc[ai][0][m][0], g1 = acc[ai][0][m][1], u0 = acc[ai][1][m][0], u1 = acc[ai][1][m][1];
                u32x4 w; w.x = cvt_pk_bf16(siluf_(g0[0]) * u0[0], siluf_(g0[1]) * u0[1]); w.y = cvt_pk_bf16(siluf_(g0[2]) * u0[2], siluf_(g0[3]) * u0[3]);
                w.z = cvt_pk_bf16(siluf_(g1[0]) * u1[0], siluf_(g1[1]) * u1[1]); w.w = cvt_pk_bf16(siluf_(g1[2]) * u1[2], siluf_(g1[3]) * u1[3]);
                __builtin_nontemporal_store(w, (u32x4*)rowp); }
    }
};
struct EpiSigMul {
    static constexpr bool PERM = true, AFTER_DRAIN = false;
    bf16_t* O; const bf16_t* U; int ldc;
    __device__ __forceinline__ void operator()(const f32x4 (&acc)[2][2][4][2], const Unit& u, int wr, int wc, int fr, int fq) const {
        const int row0 = u.pm * BM + wr * 64 + fr, col0 = u.pn * BM + wc * 32 + 8 * fq;
#pragma unroll
        for (int ai = 0; ai < 2; ++ai)
#pragma unroll
            for (int m = 0; m < 4; ++m) { const size_t off = (size_t)(row0 + ai * HALF + m * 16) * ldc + col0;
#pragma unroll
                for (int bj = 0; bj < 2; ++bj) { const f32x4 v0 = acc[ai][bj][m][0], v1 = acc[ai][bj][m][1];
                    const u32x4 uu = *(const u32x4*)(U + off + bj * HALF);
                    u32x4 w; w.x = cvt_pk_bf16(sigmoidf_(v0[0]) * bf_lo(uu.x), sigmoidf_(v0[1]) * bf_hi(uu.x)); w.y = cvt_pk_bf16(sigmoidf_(v0[2]) * bf_lo(uu.y), sigmoidf_(v0[3]) * bf_hi(uu.y));
                    w.z = cvt_pk_bf16(sigmoidf_(v1[0]) * bf_lo(uu.z), sigmoidf_(v1[1]) * bf_hi(uu.z)); w.w = cvt_pk_bf16(sigmoidf_(v1[2]) * bf_lo(uu.w), sigmoidf_(v1[3]) * bf_hi(uu.w));
                    *(u32x4*)(O + off + bj * HALF) = w; } }
    }
};
template <class Epi, class Sched, bool ALIGN_EPI = false, bool SP2 = false>
__device__ __forceinline__ void gemm_phase(PG8_LAS unsigned char* lds, const Gemm g, const Sched& S, const Epi& E) {
    const int tid = threadIdx.x, wid = __builtin_amdgcn_readfirstlane(tid >> 6), lane = tid & 63, wr = wid >> 2, wc = wid & 3, fr = lane & 15, fq = lane >> 4;
    const int K = g.K, nt = K / BK, LD = g.ld ? g.ld : g.K;
    unsigned voffA[2], voffB[2];
#pragma unroll
    for (int i = 0; i < 2; ++i) { int R, C; stage_rc(tid * 16 + i * 8192, R, C); const int Rb = Epi::PERM ? ((R & ~31) + perm32(R & 31)) : R;
        voffA[i] = (unsigned)(R * LD + C) * 2u; voffB[i] = (unsigned)(Rb * LD + C) * 2u; }
    const size_t kstep = (size_t)(BK * 2);
    const size_t hstep = (size_t)HALF * LD * 2;
    const size_t tstep = 2 * hstep;
    const unsigned ldsw = (unsigned)wid * 1024u;
    const int aoff = lds_byte(wr * 64 + fr, fq * 8), boff = lds_byte(wc * 32 + fr, fq * 8);
#define PG8_SA(b, h) (((b) * 2 + (h)) * HTB)
#define PG8_SB(b, h) ((4 + (b) * 2 + (h)) * HTB)
#define PG8_STAGE(bufoff, gbase, voff) do { _Pragma("unroll") for (int _i = 0; _i < 2; ++_i) \
        __builtin_amdgcn_global_load_lds((const unsigned*)((const char*)(gbase) + (voff)[_i]), (PG8_LAS unsigned*)(lds + (bufoff) + ldsw + _i * 8192), 16, 0, 0); } while (0)
#define PG8_LDA(dst, b, h) do { _Pragma("unroll") for (int m = 0; m < 4; ++m) _Pragma("unroll") for (int k = 0; k < 2; ++k) dst[m][k] = *(const PG8_LAS bf16x8*)(lds + PG8_SA(b, h) + aoff + m * 2048 + k * 1024); } while (0)
#define PG8_LDB(dst, b, h) do { _Pragma("unroll") for (int n = 0; n < 2; ++n) _Pragma("unroll") for (int k = 0; k < 2; ++k) dst[n][k] = *(const PG8_LAS bf16x8*)(lds + PG8_SB(b, h) + boff + n * 2048 + k * 1024); } while (0)
#define PG8_MMA(ai, bj, At, Bt) do { __builtin_amdgcn_s_setprio(1); _Pragma("unroll") for (int m = 0; m < 4; ++m) _Pragma("unroll") for (int n = 0; n < 2; ++n) _Pragma("unroll") for (int k = 0; k < 2; ++k) \
        acc[ai][bj][m][n] = __builtin_amdgcn_mfma_f32_16x16x32_bf16(Bt[n][k], At[m][k], acc[ai][bj][m][n], 0, 0, 0); __builtin_amdgcn_s_setprio(0); } while (0)
#define PG8_WAIT_V(n) asm volatile("s_waitcnt vmcnt(" #n ")" ::: "memory")
#define PG8_WAIT_L(n) asm volatile("s_waitcnt lgkmcnt(" #n ")" ::: "memory")
#define PG8_BAR __builtin_amdgcn_s_barrier()
#define PG8_SCHED __builtin_amdgcn_sched_barrier(0)
    Unit cur, nxt; int ui = 0;
    if (!S.next(0, cur)) return;
    f32x4 acc[2][2][4][2];
#pragma unroll
    for (int a = 0; a < 2; ++a)
#pragma unroll
        for (int b = 0; b < 2; ++b)
#pragma unroll
            for (int m = 0; m < 4; ++m)
#pragma unroll
                for (int n = 0; n < 2; ++n) acc[a][b][m][n] = (f32x4){0.f, 0.f, 0.f, 0.f};
    bf16x8 At[4][2], B0[2][2], B1[2][2];
    const char* cA = (const char*)g.A + (size_t)cur.pm * tstep; const char* cB = (const char*)g.Bt + (size_t)cur.pn * tstep;
    S.a_ready(cur);
    if constexpr (SP2) {
        PG8_STAGE(PG8_SB(0, 0), cB, voffB); PG8_STAGE(PG8_SB(0, 1), cB + hstep, voffB); PG8_STAGE(PG8_SA(0, 0), cA, voffA); PG8_STAGE(PG8_SA(0, 1), cA + hstep, voffA);
        if (wr == 1) PG8_BAR;
        PG8_WAIT_V(2); PG8_BAR;
        PG8_STAGE(PG8_SB(1, 0), cB + kstep, voffB); PG8_STAGE(PG8_SA(1, 0), cA + kstep, voffA); PG8_STAGE(PG8_SB(1, 1), cB + hstep + kstep, voffB);
        PG8_WAIT_V(6); PG8_BAR;
    } else {
        PG8_STAGE(PG8_SB(0, 0), cB, voffB); PG8_STAGE(PG8_SA(0, 0), cA, voffA); PG8_STAGE(PG8_SB(0, 1), cB + hstep, voffB); PG8_STAGE(PG8_SA(0, 1), cA + hstep, voffA);
        if (wr == 1) PG8_BAR;
        PG8_WAIT_V(4); PG8_BAR;
        PG8_STAGE(PG8_SB(1, 0), cB + kstep, voffB); PG8_STAGE(PG8_SA(1, 0), cA + kstep, voffA); PG8_STAGE(PG8_SB(1, 1), cB + hstep + kstep, voffB);
        PG8_WAIT_V(6); PG8_BAR;
    }
    for (;;) {
        const bool has_next = S.next(ui + 1, nxt);
        const char* nA = has_next ? (const char*)g.A + (size_t)nxt.pm * tstep : cA; const char* nB = has_next ? (const char*)g.Bt + (size_t)nxt.pn * tstep : cB;
        for (int t = 0; t < nt; t += 2) {
            const bool last = (t == nt - 2);
            const char* a1 = cA + (size_t)(t + 1) * kstep;
            const char* a2 = last ? nA : cA + (size_t)(t + 2) * kstep; const char* b2 = last ? nB : cB + (size_t)(t + 2) * kstep;
            const char* a3 = a2 + kstep; const char* b3 = b2 + kstep;
            if (last && has_next) S.a_ready(nxt);
            if constexpr (SP2) {
            PG8_LDB(B0, 0, 0); PG8_LDB(B1, 0, 1); PG8_SCHED; PG8_LDA(At, 0, 0); PG8_STAGE(PG8_SA(1, 1), a1 + hstep, voffA);
            PG8_WAIT_V(8); PG8_WAIT_L(0); PG8_BAR; PG8_MMA(0, 0, At, B0); PG8_MMA(0, 1, At, B1); PG8_BAR; PG8_SCHED;
            PG8_LDA(At, 0, 1); PG8_STAGE(PG8_SB(0, 0), b2, voffB); PG8_STAGE(PG8_SB(0, 1), b2 + hstep, voffB); PG8_STAGE(PG8_SA(0, 0), a2, voffA);
            PG8_WAIT_V(8); PG8_WAIT_L(0); PG8_BAR; PG8_MMA(1, 0, At, B0); PG8_MMA(1, 1, At, B1); PG8_BAR; PG8_SCHED;
            PG8_LDB(B0, 1, 0); PG8_LDB(B1, 1, 1); PG8_SCHED; PG8_LDA(At, 1, 0); PG8_STAGE(PG8_SA(0, 1), a2 + hstep, voffA);
            PG8_WAIT_V(8); PG8_WAIT_L(0); PG8_BAR; PG8_MMA(0, 0, At, B0); PG8_MMA(0, 1, At, B1); PG8_BAR; PG8_SCHED;
            PG8_LDA(At, 1, 1); PG8_STAGE(PG8_SB(1, 0), b3, voffB); PG8_STAGE(PG8_SB(1, 1), b3 + hstep, voffB); PG8_STAGE(PG8_SA(1, 0), a3, voffA);
            PG8_WAIT_V(8); PG8_WAIT_L(0); PG8_BAR; PG8_MMA(1, 0, At, B0); PG8_MMA(1, 1, At, B1); PG8_BAR; PG8_SCHED;
            } else {
            PG8_LDB(B0, 0, 0); PG8_SCHED; PG8_LDA(At, 0, 0); PG8_STAGE(PG8_SA(1, 1), a1 + hstep, voffA);
            PG8_WAIT_L(8); PG8_BAR; PG8_WAIT_L(0); PG8_MMA(0, 0, At, B0); PG8_BAR; PG8_SCHED;
            PG8_LDB(B1, 0, 1); PG8_STAGE(PG8_SB(0, 0), b2, voffB);
            PG8_BAR; PG8_WAIT_L(0); PG8_MMA(0, 1, At, B1); PG8_BAR;
            PG8_LDA(At, 0, 1); PG8_STAGE(PG8_SA(0, 0), a2, voffA);
            PG8_BAR; PG8_WAIT_L(0); PG8_MMA(1, 0, At, B0); PG8_BAR; PG8_SCHED;
            PG8_STAGE(PG8_SB(0, 1), b2 + hstep, voffB);
            PG8_WAIT_V(6); PG8_BAR; PG8_MMA(1, 1, At, B1); PG8_BAR;
            PG8_LDB(B0, 1, 0); PG8_SCHED; PG8_LDA(At, 1, 0); PG8_STAGE(PG8_SA(0, 1), a2 + hstep, voffA);
            PG8_WAIT_L(8); PG8_BAR; PG8_WAIT_L(0); PG8_MMA(0, 0, At, B0); PG8_BAR; PG8_SCHED;
            PG8_LDB(B1, 1, 1); PG8_STAGE(PG8_SB(1, 0), b3, voffB);
            PG8_BAR; PG8_WAIT_L(0); PG8_MMA(0, 1, At, B1); PG8_BAR;
            PG8_LDA(At, 1, 1); PG8_STAGE(PG8_SA(1, 0), a3, voffA);
            PG8_BAR; PG8_WAIT_L(0); PG8_MMA(1, 0, At, B0); PG8_BAR; PG8_SCHED;
            PG8_STAGE(PG8_SB(1, 1), b3 + hstep, voffB);
            PG8_WAIT_V(6); PG8_BAR; PG8_MMA(1, 1, At, B1); PG8_BAR;
            }
        }
        if constexpr (ALIGN_EPI) { if (wr == 0) PG8_BAR; }
        if constexpr (!Epi::AFTER_DRAIN) { E(acc, cur, wr, wc, fr, fq); S.done(cur); }
        if (!has_next) break;
#pragma unroll
        for (int a = 0; a < 2; ++a)
#pragma unroll
            for (int b = 0; b < 2; ++b)
#pragma unroll
                for (int m = 0; m < 4; ++m)
#pragma unroll
                    for (int n = 0; n < 2; ++n) acc[a][b][m][n] = (f32x4){0.f, 0.f, 0.f, 0.f};
        cur = nxt; cA = nA; cB = nB; ++ui;
        if constexpr (ALIGN_EPI) { if (wr == 1) PG8_BAR; }
    }
    PG8_WAIT_V(0);
    if constexpr (!ALIGN_EPI) { if (wr == 0) PG8_BAR; }
    PG8_BAR;
    if constexpr (Epi::AFTER_DRAIN) { E.fused(acc, cur, wr, wc, fr, fq, lds, wid, lane); S.done(cur); }
#undef PG8_SA
#undef PG8_SB
#undef PG8_STAGE
#undef PG8_LDA
#undef PG8_LDB
#undef PG8_MMA
#undef PG8_WAIT_V
#undef PG8_WAIT_L
#undef PG8_BAR
#undef PG8_SCHED
}
}
#define LAS __attribute__((address_space(3)))
using pg8::bf16_t; using pg8::bf16x8; using pg8::f32x4; using pg8::u32x4; using pg8::cvt_pk_bf16; using pg8::bf_lo; using pg8::bf_hi; using pg8::sigmoidf_; using pg8::siluf_;
typedef unsigned u32x2 __attribute__((ext_vector_type(2)));
constexpr int NWAVES = 8, NTHR = 512;
constexpr int MP = 32768, MS = 2048, M = MP + MS, D = 2048, FF = 5632, DIN = 5632, PLE = 256;
constexpr int ZQ = 0, ZK = 1024, ZV = 1280, ZHQ = 1536, ZHF = 2560, ZHI = 3584, ZHG = 4608;
constexpr float EPS = 1e-6f;
constexpr size_t MiB = 1u << 20;
constexpr size_t WS_CTL = 0, CTL_BYTES = 65536;
constexpr size_t WS_W1GU = 1 * MiB, WS_W1D = WS_W1GU + 44 * MiB, WS_WIN = WS_W1D + 22 * MiB, WS_WOUT = WS_WIN + 22 * MiB, WS_W2GU = WS_WOUT + 8 * MiB, WS_W2D = WS_W2GU + 44 * MiB,
                 WS_WPG = WS_W2D + 22 * MiB, WS_WPP = WS_WPG + 8 * MiB, WS_BTAB = WS_WPP + 1 * MiB;
constexpr size_t WS_XN = WS_BTAB + 1 * MiB;
constexpr size_t WS_H = WS_XN + 136 * MiB;
constexpr size_t WS_Y = WS_H + 374 * MiB;
constexpr size_t REC_STRIDE = 27136, NREC = (size_t)(M / 32) * 8;
constexpr size_t WS_U = WS_Y + 136 * MiB;
constexpr size_t WS_PART = WS_U + 136 * MiB;
constexpr size_t WS_PB = 1007 * MiB;
constexpr size_t WS_END = WS_PB + 17 * MiB;
static_assert(WS_PART + 32 * MiB <= WS_PB && WS_U + 136 * MiB <= WS_PB && WS_Y + 228 * MiB <= WS_PB, "ws map 2");
static_assert(NREC * REC_STRIDE + 1024 <= 228 * MiB && WS_END <= 1024 * MiB, "ws map");
constexpr int R_QD = 0, R_KE = 8192, R_IT = 16384, R_A = 24576, R_DEC = 26624;
constexpr size_t O_KP = (size_t)M * D, O_VP = O_KP + 131072, O_SP = O_VP + 131072, O_KS = O_SP + 524288, O_VS = O_KS + 1048576, O_SS = O_VS + 1048576, O_END = O_SS + 4194304;
constexpr int LDS_BYTES = 147456;
constexpr int CW_QUEUE = 0, CW_BAR = 1024;

struct Args { const float* in[29]; float* out; unsigned char* ws; int lo, hi; };
enum { I_XP = 0, I_XS, I_CK, I_CV, I_ST, I_PP, I_PS, I_TAB, I_F1PRE, I_F1POST, I_F1G, I_F1U, I_F1D, I_MPRE, I_MPOST, I_WIN, I_WOUT, I_SINK, I_LB, I_HN, I_F2PRE, I_F2POST, I_F2G, I_F2U, I_F2D, I_PPRE, I_PPOST, I_WPG, I_WPP };

__device__ __forceinline__ float wave_sum(float v) {
#pragma unroll
    for (int o = 1; o < 64; o <<= 1) v += __shfl_xor(v, o);
    return v;
}
#define LDS_WAIT() asm volatile("s_waitcnt lgkmcnt(0)" ::: "memory")

__device__ __forceinline__ void transpose_item(const float* W, int K, int N, bf16_t* WT, int k0, int n0, int drow0, LAS float* scr, int lane) {
    asm volatile("" : "+v"(lane)); __builtin_assume(lane >= 0 && lane < 64);
#pragma unroll 8
    for (int i = 0; i < 32; ++i) { const int kk = 2 * i + (lane >> 5); scr[kk * 33 + (lane & 31)] = __builtin_nontemporal_load(&W[(size_t)(k0 + kk) * N + n0 + (lane & 31)]); }
    LDS_WAIT();
    const int c = lane & 7;
#pragma unroll
    for (int j = 0; j < 4; ++j) { const int n = (lane >> 3) + 8 * j; const LAS float* s = scr + (8 * c) * 33 + n;
        u32x4 o; o.x = cvt_pk_bf16(s[0 * 33], s[1 * 33]); o.y = cvt_pk_bf16(s[2 * 33], s[3 * 33]); o.z = cvt_pk_bf16(s[4 * 33], s[5 * 33]); o.w = cvt_pk_bf16(s[6 * 33], s[7 * 33]);
        *(u32x4*)(WT + (size_t)(drow0 + n) * K + k0 + 8 * c) = o; }
    LDS_WAIT();
}
__device__ __forceinline__ bool transpose_mat(int& r, const float* W, int K, int N, bf16_t* WT, int mode, LAS float* scr, int lane) {
    const int nblk = N / 32, items = (K / 64) * nblk;
    if (r >= items) { r -= items; return false; }
    const int kb = r / nblk, nb = r % nblk, n0 = 32 * nb;
    const int drow0 = mode == 0 ? n0 : (n0 / 128) * 256 + (n0 % 128) + (mode == 2 ? 128 : 0);
    transpose_item(W, K, N, WT, 64 * kb, n0, drow0, scr, lane);
    return true;
}
__device__ __forceinline__ void rms_row_to_bf16(const f32x4 (&v)[8], const float* gain, bf16_t* orow, int lane) {
    const f32x4* gr = (const f32x4*)gain + lane;
    float s = 0.f;
#pragma unroll
    for (int j = 0; j < 8; ++j) s += (v[j].x * v[j].x + v[j].y * v[j].y) + (v[j].z * v[j].z + v[j].w * v[j].w);
    const float rstd = rsqrtf(wave_sum(s) * (1.f / D) + EPS);
    u32x2* o8 = (u32x2*)orow + lane;
#pragma unroll
    for (int j = 0; j < 8; ++j) { const f32x4 g = gr[64 * j]; u32x2 w; w.x = cvt_pk_bf16(v[j].x * rstd * g.x, v[j].y * rstd * g.y); w.y = cvt_pk_bf16(v[j].z * rstd * g.z, v[j].w * rstd * g.w); o8[64 * j] = w; }
}
__device__ __forceinline__ void norm_load_y(const bf16_t* Y, const float* PART, int m, int lane, u32x2 (&y)[8]) {
    const u32x2* yr = (const u32x2*)(Y + (size_t)m * D) + lane;
#pragma unroll
    for (int j = 0; j < 8; ++j) y[j] = __builtin_nontemporal_load(&yr[64 * j]);
    const int pm = m >> 8, q = pm - 16;
    if (PART && q >= 0 && (q & 15) < 8) {
        const int pn = q >> 4, c = (q & 15) * 8 + pn;
        const float* pa = PART + ((size_t)(2 * c) * 256 + (m & 255)) * 256 + 4 * lane;
        const f32x4 a = *(const f32x4*)pa, b = *(const f32x4*)(pa + 65536);
        u32x2 w; w.x = cvt_pk_bf16(a.x + b.x, a.y + b.y); w.y = cvt_pk_bf16(a.z + b.z, a.w + b.w);
#pragma unroll
        for (int j = 0; j < 8; ++j) if (j == pn) y[j] = w;
    }
}
template <bool XIN_BF, bool XOUT_BF>
__device__ __forceinline__ void norm_load_x(const float* xp, const float* xs, const bf16_t* xb, int m, int lane, f32x4 (&v)[8]) {
    if (XIN_BF) { const u32x2* xr = (const u32x2*)(xb + (size_t)m * D) + lane;
#pragma unroll
        for (int j = 0; j < 8; ++j) { const u32x2 w = __builtin_nontemporal_load(&xr[64 * j]); v[j] = (f32x4){bf_lo(w.x), bf_hi(w.x), bf_lo(w.y), bf_hi(w.y)}; }
    } else { const float* xrow = (m < MP) ? xp + (size_t)m * D : xs + (size_t)(m - MP) * D; const f32x4* xr = (const f32x4*)xrow + lane;
#pragma unroll
        for (int j = 0; j < 8; ++j) v[j] = __builtin_nontemporal_load(&xr[64 * j]); }
}
template <bool XIN_BF, bool XOUT_BF>
__device__ __forceinline__ void norm_pass(const float* xp, const float* xs, const bf16_t* xbin, const bf16_t* Y, const float* post, float scale, const float* pre, float* X, bf16_t* xbout, bf16_t* XN, int gw, int NGW, int lane, const float* PART = nullptr) {
    f32x4 v[8]; u32x2 y[8];
    norm_load_x<XIN_BF, XOUT_BF>(xp, xs, xbin, gw, lane, v); norm_load_y(Y, PART, gw, lane, y);
    for (int m = gw; m < M; m += NGW) {
        f32x4 vn[8]; u32x2 yn[8];
        const int mn = m + NGW < M ? m + NGW : m;
        norm_load_x<XIN_BF, XOUT_BF>(xp, xs, xbin, mn, lane, vn); norm_load_y(Y, PART, mn, lane, yn);
        float s = 0.f;
#pragma unroll
        for (int j = 0; j < 8; ++j) { const float a = bf_lo(y[j].x), b = bf_hi(y[j].x), c = bf_lo(y[j].y), d = bf_hi(y[j].y); s += (a * a + b * b) + (c * c + d * d); }
        const float rs = rsqrtf(wave_sum(s) * (1.f / D) + EPS) * scale; float s2 = 0.f;
#pragma unroll
        for (int j = 0; j < 8; ++j) { const f32x4 g = ((const f32x4*)post + lane)[64 * j];
            v[j].x += bf_lo(y[j].x) * rs * g.x; v[j].y += bf_hi(y[j].x) * rs * g.y; v[j].z += bf_lo(y[j].y) * rs * g.z; v[j].w += bf_hi(y[j].y) * rs * g.w;
            s2 += (v[j].x * v[j].x + v[j].y * v[j].y) + (v[j].z * v[j].z + v[j].w * v[j].w);
            if (XOUT_BF) { u32x2 w; w.x = cvt_pk_bf16(v[j].x, v[j].y); w.y = cvt_pk_bf16(v[j].z, v[j].w); __builtin_nontemporal_store(w, &((u32x2*)(xbout + (size_t)m * D) + lane)[64 * j]); }
            else __builtin_nontemporal_store(v[j], &((f32x4*)(X + (size_t)m * D) + lane)[64 * j]); }
        if (pre) {
            const float r2 = rsqrtf(wave_sum(s2) * (1.f / D) + EPS); u32x2* o8 = (u32x2*)(XN + (size_t)m * D) + lane;
#pragma unroll
            for (int j = 0; j < 8; ++j) { const f32x4 g = ((const f32x4*)pre + lane)[64 * j]; u32x2 w; w.x = cvt_pk_bf16(v[j].x * r2 * g.x, v[j].y * r2 * g.y); w.y = cvt_pk_bf16(v[j].z * r2 * g.z, v[j].w * r2 * g.w); o8[64 * j] = w; }
        }
#pragma unroll
        for (int j = 0; j < 8; ++j) { v[j] = vn[j]; y[j] = yn[j]; }
    }
}
constexpr int PREP_WSTRIDE = 2 * 32 * 132 * 2;
typedef short bf16x4 __attribute__((ext_vector_type(4)));
__device__ __forceinline__ void hgrn_prep_item(const bf16_t* Z, const float* lbl, unsigned char* REC, int cidx, int h, LAS unsigned char* wl, int lane) {
    asm volatile("" : "+v"(lane)); __builtin_assume(lane >= 0 && lane < 64);
    LAS bf16_t* Xs = (LAS bf16_t*)wl; LAS bf16_t* Ys = Xs + 32 * 132;
    const int k0 = 2 * lane, m0 = cidx * 32, c16 = lane & 15, g = lane >> 4;
    float lb[2], omlb[2], cum[2] = {0.f, 0.f};
#pragma unroll
    for (int e = 0; e < 2; ++e) { const float l0 = lbl[h * 128 + k0 + e], l1 = lbl[1024 + h * 128 + k0 + e]; lb[e] = __builtin_amdgcn_rcpf(1.f + __expf(l1 - l0)); omlb[e] = 1.f - lb[e]; }
    float cv[32][2]; unsigned omp[32], qraw[32], itp[2][16];
    const bf16_t* zr = Z + (size_t)m0 * DIN + h * 128 + k0;
#pragma unroll
    for (int t = 0; t < 32; ++t) {
        const unsigned ff = *(const unsigned*)(zr + (size_t)t * DIN + ZHF), ii = *(const unsigned*)(zr + (size_t)t * DIN + ZHI);
        qraw[t] = *(const unsigned*)(zr + (size_t)t * DIN + ZHQ); float omv[2];
#pragma unroll
        for (int e = 0; e < 2; ++e) {
            const float fl = e ? bf_hi(ff) : bf_lo(ff);
            const float ex = __expf(-fl), sg = __builtin_amdgcn_rcpf(1.f + ex);
            const float f = lb[e] + omlb[e] * sg;
            omv[e] = omlb[e] * (ex * sg);
            cum[e] += __logf(f); cv[t][e] = cum[e];
        }
        omp[t] = cvt_pk_bf16(omv[0], omv[1]);
        if ((t & 1) == 0) { itp[0][t >> 1] = ii & 0xffffu; itp[1][t >> 1] = ii >> 16; }
        else { itp[0][t >> 1] |= ii << 16; itp[1][t >> 1] |= ii & 0xffff0000u; }
        if ((t & 15) == 15) asm volatile("" ::: "memory");
    }
    unsigned char* R = REC + ((size_t)cidx * 8 + h) * REC_STRIDE;
    {   u32x4* it = (u32x4*)(R + R_IT + k0 * 64);
#pragma unroll
        for (int e = 0; e < 2; ++e)
#pragma unroll
            for (int q4 = 0; q4 < 4; ++q4) it[4 * e + q4] = (u32x4){itp[e][4 * q4], itp[e][4 * q4 + 1], itp[e][4 * q4 + 2], itp[e][4 * q4 + 3]}; }
#pragma unroll
    for (int t = 0; t < 32; ++t) {
        const float q0 = bf_lo(qraw[t]), q1 = bf_hi(qraw[t]);
        *(LAS unsigned*)(Xs + t * 132 + k0) = cvt_pk_bf16(q0 * __expf(cv[t][0]), q1 * __expf(cv[t][1]));
        *(LAS unsigned*)(Ys + t * 132 + k0) = cvt_pk_bf16(bf_lo(omp[t]) * __expf(cv[15][0] - cv[t][0]), bf_hi(omp[t]) * __expf(cv[15][1] - cv[t][1]));
    }
    {
        u32x4* ke = (u32x4*)(R + R_KE + k0 * 64);
#pragma unroll
        for (int e = 0; e < 2; ++e) {
            unsigned kep[16];
#pragma unroll
            for (int t2 = 0; t2 < 16; ++t2) kep[t2] = cvt_pk_bf16((e ? bf_hi(omp[2 * t2]) : bf_lo(omp[2 * t2])) * __expf(cum[e] - cv[2 * t2][e]), (e ? bf_hi(omp[2 * t2 + 1]) : bf_lo(omp[2 * t2 + 1])) * __expf(cum[e] - cv[2 * t2 + 1][e]));
#pragma unroll
            for (int q4 = 0; q4 < 4; ++q4) { ke[4 * e + q4] = (u32x4){kep[4 * q4], kep[4 * q4 + 1], kep[4 * q4 + 2], kep[4 * q4 + 3]}; }
        }
        float2 dd; dd.x = __expf(cum[0]); dd.y = __expf(cum[1]); *(float2*)(R + R_DEC + k0 * 4) = dd;
    }
    LDS_WAIT();
#pragma unroll
    for (int tb = 0; tb < 2; ++tb)
#pragma unroll
        for (int kk = 0; kk < 4; ++kk) {
            const u32x2 lo = *(const LAS u32x2*)(Xs + (16 * tb + c16) * 132 + 32 * kk + 4 * g), hi = *(const LAS u32x2*)(Xs + (16 * tb + c16) * 132 + 32 * kk + 16 + 4 * g);
            *(u32x4*)(R + R_QD + ((tb * 4 + kk) * 64 + lane) * 16) = (u32x4){lo.x, lo.y, hi.x, hi.y};
        }
    LDS_WAIT();
#pragma unroll
    for (int t = 0; t < 32; ++t) {
        const float q0 = bf_lo(qraw[t]), q1 = bf_hi(qraw[t]);
        *(LAS unsigned*)(Xs + t * 132 + k0) = cvt_pk_bf16(q0 * __expf(cv[t][0] - cv[15][0]), q1 * __expf(cv[t][1] - cv[15][1]));
    }
    LDS_WAIT();
    f32x4 a00 = {0.f, 0.f, 0.f, 0.f}, a10 = a00, a11 = a00;
#pragma unroll
    for (int kk = 0; kk < 4; ++kk) {
        bf16x8 qf[2], kf[2];
#pragma unroll
        for (int b = 0; b < 2; ++b) {
            const u32x2 qlo = *(const LAS u32x2*)(Xs + (16 * b + c16) * 132 + 32 * kk + 4 * g), qhi = *(const LAS u32x2*)(Xs + (16 * b + c16) * 132 + 32 * kk + 16 + 4 * g);
            const u32x2 klo = *(const LAS u32x2*)(Ys + (16 * b + c16) * 132 + 32 * kk + 4 * g), khi = *(const LAS u32x2*)(Ys + (16 * b + c16) * 132 + 32 * kk + 16 + 4 * g);
            qf[b] = __builtin_bit_cast(bf16x8, ((u32x4){qlo.x, qlo.y, qhi.x, qhi.y})); kf[b] = __builtin_bit_cast(bf16x8, ((u32x4){klo.x, klo.y, khi.x, khi.y}));
        }
        a00 = __builtin_amdgcn_mfma_f32_16x16x32_bf16(kf[0], qf[0], a00, 0, 0, 0);
        a10 = __builtin_amdgcn_mfma_f32_16x16x32_bf16(kf[0], qf[1], a10, 0, 0, 0);
        a11 = __builtin_amdgcn_mfma_f32_16x16x32_bf16(kf[1], qf[1], a11, 0, 0, 0);
    }
#pragma unroll
    for (int i = 0; i < 4; ++i) if (4 * g + i > c16) { a00[i] = 0.f; a11[i] = 0.f; }
    u32x2 w;
    w.x = cvt_pk_bf16(a00[0], a00[1]); w.y = cvt_pk_bf16(a00[2], a00[3]); *(u32x2*)(R + R_A + (c16 * 32 + 4 * g) * 2) = w;
    w.x = 0u; w.y = 0u; *(u32x2*)(R + R_A + (c16 * 32 + 16 + 4 * g) * 2) = w;
    w.x = cvt_pk_bf16(a10[0], a10[1]); w.y = cvt_pk_bf16(a10[2], a10[3]); *(u32x2*)(R + R_A + ((16 + c16) * 32 + 4 * g) * 2) = w;
    w.x = cvt_pk_bf16(a11[0], a11[1]); w.y = cvt_pk_bf16(a11[2], a11[3]); *(u32x2*)(R + R_A + ((16 + c16) * 32 + 16 + 4 * g) * 2) = w;
    LDS_WAIT();
}

constexpr int CH_NS = 4, CH_SLOT = 27648;
static_assert(CH_NS * CH_SLOT <= 131072, "chain LDS");
#define CH_RAWBAR() do { asm volatile("s_waitcnt lgkmcnt(0)" ::: "memory"); __builtin_amdgcn_s_barrier(); asm volatile("" ::: "memory"); } while (0)
__device__ __forceinline__ void ch_issue(const unsigned char* Rl, LAS unsigned char* dst, int wave) {
    __builtin_amdgcn_global_load_lds((const unsigned*)(Rl + wave * 1024), (LAS unsigned*)(dst + wave * 1024), 16, 0, 0);
    __builtin_amdgcn_global_load_lds((const unsigned*)(Rl + (wave + 8) * 1024), (LAS unsigned*)(dst + (wave + 8) * 1024), 16, 0, 0);
    __builtin_amdgcn_global_load_lds((const unsigned*)(Rl + (wave + 16) * 1024), (LAS unsigned*)(dst + (wave + 16) * 1024), 16, 0, 0);
    if (wave < 3) __builtin_amdgcn_global_load_lds((const unsigned*)(Rl + (wave + 24) * 1024), (LAS unsigned*)(dst + (wave + 24) * 1024), 16, 0, 0);
}
#define CH_WAITN(N) asm volatile("s_waitcnt vmcnt(%0)" :: "n"(N) : "memory")
#define CH_WAIT(EX) do { if (wave < 3) CH_WAITN(8 + (EX)); else if (wave == 3) CH_WAITN(6 + (EX)); else CH_WAITN(6); } while (0)
__device__ __forceinline__ void hgrn_chain(const unsigned char* REC, const float* s0, float* sout, bf16_t* MIX,
                                           int cidx0, int nchunks, int h, int vhalf, LAS unsigned char* lds, int wave, int lane) {
    asm volatile("" : "+v"(lane)); __builtin_assume(lane >= 0 && lane < 64);
    const int c16 = lane & 15, g = lane >> 4, v0 = 64 * vhalf + 16 * (wave & 3);
    const bool comp = wave < 4;
    f32x4 S[8];
#pragma unroll
    for (int kb = 0; kb < 8; ++kb)
#pragma unroll
        for (int i = 0; i < 4; ++i) S[kb][i] = (s0 && comp) ? s0[(size_t)(16 * kb + 4 * g + i) * 128 + v0 + c16] : 0.f;
    bf16_t* mo = MIX + (size_t)(cidx0 * 32 + c16) * D + 1024 + h * 128 + v0 + 4 * g;
    const unsigned char* Rl = REC + ((size_t)cidx0 * 8 + h) * REC_STRIDE + lane * 16;
    const unsigned char* Rlast = Rl + (size_t)(nchunks - 1) * 8 * REC_STRIDE;
    asm volatile("s_waitcnt vmcnt(0)" ::: "memory");
    const unsigned char* Ri = Rl;
#pragma unroll
    for (int cc = 0; cc < CH_NS - 1; ++cc) { ch_issue(Ri, lds + cc * CH_SLOT, wave); Ri = Ri < Rlast ? Ri + 8 * REC_STRIDE : Rlast; }
    CH_WAIT(0);
    CH_RAWBAR();
    int slot = 0, islot = CH_NS - 1;
    for (int c = 0; c < nchunks; ++c) {
        ch_issue(Ri, lds + islot * CH_SLOT, wave); Ri = Ri < Rlast ? Ri + 8 * REC_STRIDE : Rlast;
        islot = islot == CH_NS - 1 ? 0 : islot + 1;
        const LAS unsigned char* R = lds + slot * CH_SLOT;
        slot = slot == CH_NS - 1 ? 0 : slot + 1;
        if (comp) {
            bf16x8 QDf[2][4], KEf[8], ITf, Af[2]; f32x4 DEC[8];
#pragma unroll
            for (int kb = 0; kb < 8; ++kb) { DEC[kb] = *(const LAS f32x4*)(R + R_DEC + (16 * kb + 4 * g) * 4); KEf[kb] = *(const LAS bf16x8*)(R + R_KE + ((16 * kb + c16) * 32 + 8 * g) * 2); }
            ITf = *(const LAS bf16x8*)(R + R_IT + ((v0 + c16) * 32 + 8 * g) * 2);
#pragma unroll
            for (int tb = 0; tb < 2; ++tb) {
                Af[tb] = *(const LAS bf16x8*)(R + R_A + ((16 * tb + c16) * 32 + 8 * g) * 2);
#pragma unroll
                for (int kk = 0; kk < 4; ++kk) QDf[tb][kk] = *(const LAS bf16x8*)(R + R_QD + ((tb * 4 + kk) * 64 + lane) * 16);
            }
            bf16x8 Sb[4];
#pragma unroll
            for (int kk = 0; kk < 4; ++kk) {
                u32x4 sb; sb.x = cvt_pk_bf16(S[2 * kk][0], S[2 * kk][1]); sb.y = cvt_pk_bf16(S[2 * kk][2], S[2 * kk][3]);
                sb.z = cvt_pk_bf16(S[2 * kk + 1][0], S[2 * kk + 1][1]); sb.w = cvt_pk_bf16(S[2 * kk + 1][2], S[2 * kk + 1][3]);
                Sb[kk] = __builtin_bit_cast(bf16x8, sb);
            }
#pragma unroll
            for (int kb = 0; kb < 8; ++kb) S[kb] = __builtin_amdgcn_mfma_f32_16x16x32_bf16(KEf[kb], ITf, S[kb] * DEC[kb], 0, 0, 0);
            f32x4 o0 = {0.f, 0.f, 0.f, 0.f}, o1 = o0;
            o0 = __builtin_amdgcn_mfma_f32_16x16x32_bf16(ITf, Af[0], o0, 0, 0, 0);
            o1 = __builtin_amdgcn_mfma_f32_16x16x32_bf16(ITf, Af[1], o1, 0, 0, 0);
#pragma unroll
            for (int kk = 0; kk < 4; ++kk) { o0 = __builtin_amdgcn_mfma_f32_16x16x32_bf16(Sb[kk], QDf[0][kk], o0, 0, 0, 0); o1 = __builtin_amdgcn_mfma_f32_16x16x32_bf16(Sb[kk], QDf[1][kk], o1, 0, 0, 0); }
            u32x2 w; w.x = cvt_pk_bf16(o0[0], o0[1]); w.y = cvt_pk_bf16(o0[2], o0[3]);
            *(u32x2*)(mo + (size_t)c * 32 * D) = w;
            w.x = cvt_pk_bf16(o1[0], o1[1]); w.y = cvt_pk_bf16(o1[2], o1[3]);
            *(u32x2*)(mo + (size_t)c * 32 * D + (size_t)16 * D) = w;
        }
        if (c == 0) CH_WAIT(2); else if (c == 1) CH_WAIT(4); else CH_WAIT(6);
        CH_RAWBAR();
    }
    if (comp) {
#pragma unroll
        for (int kb = 0; kb < 8; ++kb)
#pragma unroll
            for (int i = 0; i < 4; ++i) sout[(size_t)(16 * kb + 4 * g + i) * 128 + v0 + c16] = S[kb][i];
    }
    asm volatile("s_waitcnt vmcnt(0)" ::: "memory");
    CH_RAWBAR();
}
__device__ __forceinline__ void rec_norm_pass(const bf16_t* Z, const float* gain, bf16_t* MIX, int gw, int NGW, int lane) {
    const int part = lane & 15;
    const f32x4 g0 = *(const f32x4*)(gain + 8 * part), g1 = *(const f32x4*)(gain + 8 * part + 4);
    const int p0 = gw * 4 + (lane >> 4), NP = M * 8, step = NGW * 4;
    u32x4 ov, gv;
    { const int m = p0 >> 3, h = p0 & 7; ov = *(const u32x4*)(MIX + (size_t)m * D + 1024 + h * 128 + 8 * part); gv = __builtin_nontemporal_load((const u32x4*)(Z + (size_t)m * DIN + ZHG + h * 128 + 8 * part)); }
    for (int p = p0; p < NP; p += step) {
        const int m = p >> 3, h = p & 7, pn = p + step < NP ? p + step : p, mn = pn >> 3, hn = pn & 7;
        bf16_t* op = MIX + (size_t)m * D + 1024 + h * 128 + 8 * part;
        const u32x4 ovn = *(const u32x4*)(MIX + (size_t)mn * D + 1024 + hn * 128 + 8 * part), gvn = __builtin_nontemporal_load((const u32x4*)(Z + (size_t)mn * DIN + ZHG + hn * 128 + 8 * part));
        float x[8] = {bf_lo(ov.x), bf_hi(ov.x), bf_lo(ov.y), bf_hi(ov.y), bf_lo(ov.z), bf_hi(ov.z), bf_lo(ov.w), bf_hi(ov.w)};
        float s = 0.f;
#pragma unroll
        for (int j = 0; j < 8; ++j) s += x[j] * x[j];
        s += __shfl_xor(s, 1); s += __shfl_xor(s, 2); s += __shfl_xor(s, 4); s += __shfl_xor(s, 8);
        const float rs = rsqrtf(s * (1.f / 128.f) + EPS);
        u32x4 w;
        w.x = cvt_pk_bf16(x[0] * rs * g0.x * siluf_(bf_lo(gv.x)), x[1] * rs * g0.y * siluf_(bf_hi(gv.x)));
        w.y = cvt_pk_bf16(x[2] * rs * g0.z * siluf_(bf_lo(gv.y)), x[3] * rs * g0.w * siluf_(bf_hi(gv.y)));
        w.z = cvt_pk_bf16(x[4] * rs * g1.x * siluf_(bf_lo(gv.z)), x[5] * rs * g1.y * siluf_(bf_hi(gv.z)));
        w.w = cvt_pk_bf16(x[6] * rs * g1.z * siluf_(bf_lo(gv.w)), x[7] * rs * g1.w * siluf_(bf_hi(gv.w)));
        *(u32x4*)op = w;
        ov = ovn; gv = gvn;
    }
}
constexpr int KS_STRIDE = 136, VT_STRIDE = 196;
constexpr int ATT_KS = 0, ATT_VT = 192 * KS_STRIDE * 2, ATT_BT = ATT_VT + 128 * VT_STRIDE * 2, ATT_END = ATT_BT + 4 * 256 * 4;
static_assert(ATT_END <= 131072, "attention LDS");
__device__ __forceinline__ void attn_item(const bf16_t* Z, const float* ck, const float* cv, const float* btab, const float* sinks, bf16_t* MIX, int item, LAS unsigned char* lds, int tid, int wave, int lane) {
    asm volatile("" : "+v"(tid), "+v"(lane)); __builtin_assume(lane >= 0 && lane < 64 && tid >= 0 && tid < 512);
    LAS bf16_t* Ks = (LAS bf16_t*)(lds + ATT_KS); LAS bf16_t* VTs = (LAS bf16_t*)(lds + ATT_VT); LAS float* bts = (LAS float*)(lds + ATT_BT);
    const bool prompt = item < 1024;
    int kvh, qrow0, krow0, kmin, sidx = 0;
    if (prompt) { const int b = item >> 8, c = (item >> 1) & 127; kvh = item & 1; qrow0 = b * 8192 + c * 64; krow0 = qrow0 - 128; kmin = c == 0 ? 128 : (c == 1 ? 64 : 0); }
    else { sidx = (item - 1024) >> 1; kvh = item & 1; qrow0 = MP + sidx * 64; krow0 = qrow0 - 128; kmin = 0; }
#pragma unroll 2
    for (int it = 0; it < 6; ++it) {
        const int task = tid + NTHR * it, kq = task & 3, key = (task >> 2) % 192, ch = (task / 768) * 4 + kq;
        u32x4 kv4 = {0u, 0u, 0u, 0u}, vv4 = {0u, 0u, 0u, 0u};
        if (!prompt && key < 128) {
            const float* kp = ck + ((size_t)(sidx * 128 + key) * 2 + kvh) * 128 + ch * 8; const float* vp = cv + ((size_t)(sidx * 128 + key) * 2 + kvh) * 128 + ch * 8;
            const f32x4 a = *(const f32x4*)kp, b = *(const f32x4*)(kp + 4), c = *(const f32x4*)vp, d = *(const f32x4*)(vp + 4);
            kv4 = (u32x4){cvt_pk_bf16(a.x, a.y), cvt_pk_bf16(a.z, a.w), cvt_pk_bf16(b.x, b.y), cvt_pk_bf16(b.z, b.w)};
            vv4 = (u32x4){cvt_pk_bf16(c.x, c.y), cvt_pk_bf16(c.z, c.w), cvt_pk_bf16(d.x, d.y), cvt_pk_bf16(d.z, d.w)};
        } else if (key >= kmin) {
            const bf16_t* zp = Z + (size_t)(krow0 + key) * DIN + ZK + kvh * 128 + ch * 8;
            kv4 = *(const u32x4*)zp; vv4 = *(const u32x4*)(zp + 256);
        }
        *(LAS u32x4*)(Ks + key * KS_STRIDE + ch * 8) = kv4;
        LAS bf16_t* vt = VTs + (ch * 8) * VT_STRIDE + key;
        vt[0 * VT_STRIDE] = (bf16_t)(vv4.x & 0xffffu); vt[1 * VT_STRIDE] = (bf16_t)(vv4.x >> 16); vt[2 * VT_STRIDE] = (bf16_t)(vv4.y & 0xffffu); vt[3 * VT_STRIDE] = (bf16_t)(vv4.y >> 16);
        vt[4 * VT_STRIDE] = (bf16_t)(vv4.z & 0xffffu); vt[5 * VT_STRIDE] = (bf16_t)(vv4.z >> 16); vt[6 * VT_STRIDE] = (bf16_t)(vv4.w & 0xffffu); vt[7 * VT_STRIDE] = (bf16_t)(vv4.w >> 16);
    }
    for (int i = tid; i < 1024; i += NTHR) bts[i] = btab[(kvh * 4 + (i >> 8)) * 256 + (i & 255)];
    const int c16 = lane & 15, g = lane >> 4, gh = wave >> 1, qhalf = wave & 1, hq = kvh * 4 + gh;
    bf16x8 Qf[2][4];
#pragma unroll
    for (int nb = 0; nb < 2; ++nb)
#pragma unroll
        for (int kk = 0; kk < 4; ++kk) Qf[nb][kk] = *(const bf16x8*)(Z + (size_t)(qrow0 + qhalf * 32 + nb * 16 + c16) * DIN + ZQ + hq * 128 + 32 * kk + 8 * g);
    const float sink = sinks[hq];
    __syncthreads();
    f32x4 sacc[12][2];
#pragma unroll
    for (int mb = 0; mb < 12; ++mb) { sacc[mb][0] = (f32x4){0.f, 0.f, 0.f, 0.f}; sacc[mb][1] = (f32x4){0.f, 0.f, 0.f, 0.f};
#pragma unroll
        for (int kk = 0; kk < 4; ++kk) { const bf16x8 Kf = *(const LAS bf16x8*)(Ks + (16 * mb + c16) * KS_STRIDE + 32 * kk + 8 * g);
            sacc[mb][0] = __builtin_amdgcn_mfma_f32_16x16x32_bf16(Kf, Qf[0][kk], sacc[mb][0], 0, 0, 0);
            sacc[mb][1] = __builtin_amdgcn_mfma_f32_16x16x32_bf16(Kf, Qf[1][kk], sacc[mb][1], 0, 0, 0); } }
    float inv[2];
    const float scale = 0.08838834764831845f;
#pragma unroll
    for (int nb = 0; nb < 2; ++nb) {
        const int qidx = qhalf * 32 + nb * 16 + c16; float mx = -3.0e38f;
#pragma unroll
        for (int mb = 0; mb < 12; ++mb)
#pragma unroll
            for (int i = 0; i < 4; ++i) { const int kidx = 16 * mb + 4 * g + i; float s = sacc[mb][nb][i] * scale + bts[gh * 256 + kidx - qidx + 63]; s = kidx < kmin ? -1e30f : s; sacc[mb][nb][i] = s; mx = fmaxf(mx, s); }
        mx = fmaxf(mx, __shfl_xor(mx, 16)); mx = fmaxf(mx, __shfl_xor(mx, 32)); mx = fmaxf(mx, sink);
        float sum = 0.f;
#pragma unroll
        for (int mb = 0; mb < 12; ++mb)
#pragma unroll
            for (int i = 0; i < 4; ++i) { const float e = __expf(sacc[mb][nb][i] - mx); sum += e; sacc[mb][nb][i] = e; }
        sum += __shfl_xor(sum, 16); sum += __shfl_xor(sum, 32); sum += __expf(sink - mx);
        inv[nb] = 1.0f / sum;
    }
    bf16x8 Pf[2][6];
#pragma unroll
    for (int nb = 0; nb < 2; ++nb)
#pragma unroll
        for (int ks = 0; ks < 6; ++ks) { u32x4 p; p.x = cvt_pk_bf16(sacc[2 * ks][nb][0], sacc[2 * ks][nb][1]); p.y = cvt_pk_bf16(sacc[2 * ks][nb][2], sacc[2 * ks][nb][3]);
            p.z = cvt_pk_bf16(sacc[2 * ks + 1][nb][0], sacc[2 * ks + 1][nb][1]); p.w = cvt_pk_bf16(sacc[2 * ks + 1][nb][2], sacc[2 * ks + 1][nb][3]); Pf[nb][ks] = __builtin_bit_cast(bf16x8, p); }
#pragma unroll
    for (int db = 0; db < 8; ++db) {
        f32x4 o0 = {0.f, 0.f, 0.f, 0.f}, o1 = {0.f, 0.f, 0.f, 0.f};
#pragma unroll
        for (int ks = 0; ks < 6; ++ks) { const LAS bf16_t* vp = VTs + (16 * db + c16) * VT_STRIDE + 32 * ks + 4 * g; const u32x2 lo = *(const LAS u32x2*)vp, hi = *(const LAS u32x2*)(vp + 16);
            const bf16x8 Vf = __builtin_bit_cast(bf16x8, ((u32x4){lo.x, lo.y, hi.x, hi.y}));
            o0 = __builtin_amdgcn_mfma_f32_16x16x32_bf16(Vf, Pf[0][ks], o0, 0, 0, 0);
            o1 = __builtin_amdgcn_mfma_f32_16x16x32_bf16(Vf, Pf[1][ks], o1, 0, 0, 0); }
        o0 = o0 * inv[0]; o1 = o1 * inv[1];
        u32x2 w0, w1; w0.x = cvt_pk_bf16(o0[0], o0[1]); w0.y = cvt_pk_bf16(o0[2], o0[3]); w1.x = cvt_pk_bf16(o1[0], o1[1]); w1.y = cvt_pk_bf16(o1[2], o1[3]);
        *(u32x2*)(MIX + (size_t)(qrow0 + qhalf * 32 + c16) * D + hq * 128 + 16 * db + 4 * g) = w0;
        *(u32x2*)(MIX + (size_t)(qrow0 + qhalf * 32 + 16 + c16) * D + hq * 128 + 16 * db + 4 * g) = w1;
    }
    __syncthreads();
}
#define XB_TMO      128
#define XB_XCNT(j)  (256  + 64 * (j))
#define XB_XSUB(j)  (1280 + 64 * (j))
#define XB_XGEN(j)  (2304 + 64 * (j))
#define XB_TOP      3328
#define XB_TOPGEN   3392
#define XCD_BAR_WORDS 3456
#define XB_SPIN_CAP (1u << 18)

__device__ __forceinline__ unsigned xb_ld(unsigned* p)              { return __hip_atomic_load(p, __ATOMIC_RELAXED, __HIP_MEMORY_SCOPE_AGENT); }
__device__ __forceinline__ unsigned xb_add(unsigned* p, unsigned v) { return __hip_atomic_fetch_add(p, v, __ATOMIC_RELAXED, __HIP_MEMORY_SCOPE_AGENT); }
__device__ __forceinline__ unsigned xb_xcc_id() { return (unsigned)__builtin_amdgcn_s_getreg((3 << 11) | 20) & 0xFu; }
#define XB_SPIN(cond, bar) do { unsigned _sp = 0; while (cond) { __builtin_amdgcn_s_sleep(1); \
    if ((++_sp & 255u) == 0u) { if (xb_ld(&(bar)[XB_TMO])) break; if (_sp > XB_SPIN_CAP) { atomicAdd(&(bar)[XB_TMO], 1u); break; } } } } while (0)

struct XcdBarrier {
    unsigned* bar; unsigned x;
    volatile LAS unsigned* st;
};

__device__ __forceinline__ XcdBarrier xcd_barrier_post(unsigned* bar, volatile LAS unsigned* st) {
    XcdBarrier b; b.bar = bar; b.x = xb_xcc_id(); b.st = st;
    if (threadIdx.x == 0) (void)xb_add(&bar[XB_XCNT(b.x)], 1u);
    return b;
}
__device__ __forceinline__ void xcd_barrier_complete(unsigned* bar, unsigned x, unsigned& nloc, unsigned& nx) {
    const unsigned G = gridDim.x * gridDim.y * gridDim.z;
    unsigned sum, cnt, mine, sp = 0u;
    for (;;) {
        sum = 0u; cnt = 0u; mine = 0u;
#pragma unroll
        for (unsigned j = 0; j < 16; ++j) { const unsigned c = xb_ld(&bar[XB_XCNT(j)]); sum += c; cnt += (c > 0u) ? 1u : 0u; mine = (j == x) ? c : mine; }
        if (sum == G) break;
        __builtin_amdgcn_s_sleep(1);
        if ((++sp & 255u) == 0u) { if (xb_ld(&bar[XB_TMO])) break; if (sp > XB_SPIN_CAP) { atomicAdd(&bar[XB_TMO], 1u); break; } }
    }
    nloc = mine > 0u ? mine : 1u; nx = cnt > 0u ? cnt : 1u;
}

__device__ __forceinline__ void xcd_barrier(const XcdBarrier& b) {
    asm volatile("s_waitcnt vmcnt(0)" ::: "memory");
    __syncthreads();
    if (threadIdx.x == 0) {
        unsigned* bar = b.bar;
        __builtin_amdgcn_s_waitcnt(0);
        unsigned nloc = b.st[0], nx = b.st[1];
        if (nloc == 0u) { xcd_barrier_complete(bar, b.x, nloc, nx); b.st[0] = nloc; b.st[1] = nx; }
        const unsigned old = xb_add(&bar[XB_XSUB(b.x)], 1u);
        const unsigned gen = old / nloc;
        if (old + 1u == (gen + 1u) * nloc) {
            __builtin_amdgcn_fence(__ATOMIC_RELEASE, "agent");
            asm volatile("s_waitcnt vmcnt(0)" ::: "memory");
            const unsigned og = xb_add(&bar[XB_TOP], 1u);
            const unsigned tg = og / nx;
            if (og + 1u == (tg + 1u) * nx) xb_add(&bar[XB_TOPGEN], 1u);
            else XB_SPIN(xb_ld(&bar[XB_TOPGEN]) == tg, bar);
            __builtin_amdgcn_fence(__ATOMIC_ACQUIRE, "agent");
            xb_add(&bar[XB_XGEN(b.x)], 1u);
            asm volatile("s_waitcnt vmcnt(0)" ::: "memory");
        } else {
            XB_SPIN(xb_ld(&bar[XB_XGEN(b.x)]) == gen, bar);
            __builtin_amdgcn_fence(__ATOMIC_ACQUIRE, "agent");
            asm volatile("s_waitcnt vmcnt(0)" ::: "memory");
        }
    }
    __syncthreads();
}

constexpr int NPHASE = 16;
__global__ void __launch_bounds__(NTHR, 2) hybrid_fwd(Args args) {
    extern __shared__ __attribute__((aligned(16))) unsigned char lds_raw[];
    LAS unsigned char* lds = (LAS unsigned char*)lds_raw;
    cg::grid_group grid = cg::this_grid();
    const int tid = threadIdx.x, lane = tid & 63, wave = __builtin_amdgcn_readfirstlane(tid >> 6);
    const int G = gridDim.x, bx = blockIdx.x;
    const int gw = bx * NWAVES + wave, NGW = G * NWAVES;
    unsigned char* ws = args.ws; float* out = args.out;
    unsigned* ctl = (unsigned*)(ws + WS_CTL);
    bf16_t* W1GU = (bf16_t*)(ws + WS_W1GU); bf16_t* W1D = (bf16_t*)(ws + WS_W1D); bf16_t* WIN = (bf16_t*)(ws + WS_WIN); bf16_t* WOUT = (bf16_t*)(ws + WS_WOUT);
    bf16_t* W2GU = (bf16_t*)(ws + WS_W2GU); bf16_t* W2D = (bf16_t*)(ws + WS_W2D); bf16_t* WPG = (bf16_t*)(ws + WS_WPG); bf16_t* WPP = (bf16_t*)(ws + WS_WPP);
    float* BTAB = (float*)(ws + WS_BTAB);
    bf16_t* XN = (bf16_t*)(ws + WS_XN); bf16_t* MIX = XN; bf16_t* H = (bf16_t*)(ws + WS_H); bf16_t* Zb = H; bf16_t* U = (bf16_t*)(ws + WS_U); bf16_t* Y = (bf16_t*)(ws + WS_Y);
    bf16_t* XB0 = (bf16_t*)out; bf16_t* XB1 = (bf16_t*)(ws + WS_H);
    float* PART = (float*)(ws + WS_PART); unsigned char* REC = ws + WS_Y; bf16_t* PB = (bf16_t*)(ws + WS_PB);
    const int lo = args.lo, hi = args.hi;
#define IN(k) (lo <= (k) && (k) < hi)
#define SEAM(k) do { if (IN(k) && IN((k) + 1)) { if ((k) == 0) grid.sync(); else xcd_barrier(xbar); } } while (0)
    {   volatile LAS unsigned* bst = (volatile LAS unsigned*)(lds + 147408);
        if (tid < 2) bst[tid] = 0u;
        __syncthreads(); }
    const XcdBarrier xbar = xcd_barrier_post(ctl + CW_BAR, (volatile LAS unsigned*)(lds + 147408));

    if (IN(0)) {
        LAS float* scr = (LAS float*)(lds + wave * 16384);
        constexpr int IT_BIG = 32 * 176;
        constexpr int NITEMS = 2 * IT_BIG;
        for (int it = gw; it < NITEMS; it += NGW) {
            int r = it;
            if (transpose_mat(r, args.in[I_F1G], D, FF, W1GU, 1, scr, lane)) continue;
            transpose_mat(r, args.in[I_F1U], D, FF, W1GU, 2, scr, lane);
        }
        f32x4 xv[8];
        { const f32x4* xr = (const f32x4*)(args.in[I_XP] + (size_t)gw * D) + lane;
#pragma unroll
          for (int j = 0; j < 8; ++j) xv[j] = __builtin_nontemporal_load(&xr[64 * j]); }
        for (int m = gw; m < M; m += NGW) {
            const int mn = m + NGW < M ? m + NGW : m;
            const float* xrow = (mn < MP) ? args.in[I_XP] + (size_t)mn * D : args.in[I_XS] + (size_t)(mn - MP) * D;
            f32x4 xn[8];
#pragma unroll
            for (int j = 0; j < 8; ++j) xn[j] = __builtin_nontemporal_load(&((const f32x4*)xrow + lane)[64 * j]);
            rms_row_to_bf16(xv, args.in[I_F1PRE], XN + (size_t)m * D, lane);
#pragma unroll
            for (int j = 0; j < 8; ++j) xv[j] = xn[j];
            const float* prow = (m < MP) ? args.in[I_PP] + (size_t)m * PLE : args.in[I_PS] + (size_t)(m - MP) * PLE;
            const f32x4 pv = __builtin_nontemporal_load(&((const f32x4*)prow)[lane]); u32x2 w; w.x = cvt_pk_bf16(pv.x, pv.y); w.y = cvt_pk_bf16(pv.z, pv.w);
            ((u32x2*)(PB + (size_t)m * PLE))[lane] = w;
        }
        if (bx == 0) {
            for (int i = tid; i < 8 * 256; i += NTHR) {
                const int h = i >> 8, idx = i & 255, rel = idx - 191, n = rel < 0 ? -rel : rel;
                const int large = 8 + (n >= 12) + (n >= 16) + (n >= 23) + (n >= 32) + (n >= 46) + (n >= 64) + (n >= 91);
                const int bucket = (rel > 0 ? 16 : 0) + (n < 8 ? n : large);
                BTAB[i] = args.in[I_TAB][bucket * 8 + h];
            }
        }
    }
    SEAM(0);
    if (IN(1)) { { pg8::Gemm g{XN, W1GU, M, 2 * FF, D}; pg8::StaticOrder S; S.wgm = 4; S.init(M, 2 * FF, G, bx); pg8::EpiSwiGLU E{H, FF};
        pg8::gemm_phase<pg8::EpiSwiGLU, pg8::StaticOrder, true, true>(lds, g, S, E); }
        if (bx >= 96) { LAS float* scr = (LAS float*)(lds + wave * 16384); constexpr int IT_BIG = 32 * 176;
            for (int it = (bx - 96) * NWAVES + wave; it < 2 * IT_BIG; it += 160 * NWAVES) { int r = it;
                if (transpose_mat(r, args.in[I_F1D], FF, D, W1D, 0, scr, lane)) continue;
                transpose_mat(r, args.in[I_WIN], D, DIN, WIN, 0, scr, lane); } } }
    SEAM(1);
    if (IN(2)) {
        { pg8::Gemm g{H, W1D, M, D, FF}; pg8::RangeOrder<0, 4> S; S.init(M, D, G, bx); pg8::EpiBf16 E{Y, D};
          pg8::gemm_phase<pg8::EpiBf16, pg8::RangeOrder<0, 4>, true, true>(lds, g, S, E); }
        if (bx < 128) { const int hk = (bx & 1) * (FF / 2);
            pg8::Gemm g{H + hk, W1D + hk, M, D, FF / 2, FF}; pg8::RangeOrder<4, 5> S; S.init(M, D, G, bx >> 1); pg8::EpiF32Tile E{PART + (size_t)bx * 65536};
            pg8::gemm_phase<pg8::EpiF32Tile, pg8::RangeOrder<4, 5>, true, true>(lds, g, S, E); }
        else { LAS float* scr = (LAS float*)(lds + wave * 16384); constexpr int IT_BIG = 32 * 176;
            for (int it = (bx - 128) * NWAVES + wave; it < 2 * IT_BIG; it += 128 * NWAVES) { int r = it;
                if (transpose_mat(r, args.in[I_F2G], D, FF, W2GU, 1, scr, lane)) continue;
                transpose_mat(r, args.in[I_F2U], D, FF, W2GU, 2, scr, lane); } } }
    SEAM(2);
    if (IN(3)) norm_pass<false, true>(args.in[I_XP], args.in[I_XS], nullptr, Y, args.in[I_F1POST], 0.5f, args.in[I_MPRE], nullptr, XB0, XN, gw, NGW, lane, PART);
    SEAM(3);
    if (IN(4)) { { pg8::Gemm g{XN, WIN, M, DIN, D}; pg8::StaticOrder S; S.wgm = 4; S.init(M, DIN, G, bx); pg8::EpiBf16 E{Zb, DIN, true};
        pg8::gemm_phase<pg8::EpiBf16, pg8::StaticOrder, true, true>(lds, g, S, E); }
        if (bx >= 176) { LAS float* scr = (LAS float*)(lds + wave * 16384); constexpr int IT_SQ = 32 * 64, IT_PP = 4 * 64;
            for (int it = (bx - 176) * NWAVES + wave; it < IT_SQ + IT_PP; it += 80 * NWAVES) { int r = it;
                if (transpose_mat(r, args.in[I_WOUT], D, D, WOUT, 0, scr, lane)) continue;
                transpose_mat(r, args.in[I_WPP], PLE, D, WPP, 0, scr, lane); } } }
    SEAM(4);
    if (IN(5)) {
        for (int cidx = bx; cidx < M / 32; cidx += G) hgrn_prep_item(Zb, args.in[I_LB], REC, cidx, wave, lds + wave * PREP_WSTRIDE, lane);
        const int gt = bx * NTHR + tid, NGT = G * NTHR;
        for (int idx = gt; idx < 2 * (131072 + 1048576); idx += NGT) {
            if (idx < 262144) { const int which = idx >> 17, r = idx & 131071, b = r >> 15, j = (r >> 8) & 127, c = r & 255;
                out[O_KP + idx] = __uint_as_float((unsigned)Zb[(size_t)(b * 8192 + 8064 + j) * DIN + ZK + which * 256 + c] << 16); }
            else { const int r2 = idx - 262144, which = r2 >> 20, r = r2 & 1048575, s = r >> 15, j = (r >> 8) & 127, c = r & 255;
                float v;
                if (j < 64) v = args.in[which ? I_CV : I_CK][(size_t)(s * 128 + 64 + j) * 256 + c];
                else v = __uint_as_float((unsigned)Zb[(size_t)(MP + s * 64 + j - 64) * DIN + ZK + which * 256 + c] << 16);
                out[O_KS + r2] = v; }
        }
    }
    SEAM(5);
    if (IN(6)) {
        LAS int* qslot = (LAS int*)(lds + 147392);
        constexpr int N_PCH = 64, N_ATT = 1088, N_SCH = 512, N_ALL = N_PCH + N_ATT + N_SCH;
        for (;;) {
            if (tid == 0) *qslot = (int)atomicAdd(ctl + CW_QUEUE, 1u);
            __syncthreads();
            const int it = *qslot;
            __syncthreads();
            if (it >= N_ALL) break;
            if (it < N_PCH) { const int ch = it >> 1, b = ch >> 3, h = ch & 7;
                hgrn_chain(REC, nullptr, out + O_SP + (size_t)ch * 16384, MIX, b * 256, 256, h, it & 1, lds, wave, lane); }
            else if (it < N_PCH + N_ATT) attn_item(Zb, args.in[I_CK], args.in[I_CV], BTAB, args.in[I_SINK], MIX, it - N_PCH, lds, tid, wave, lane);
            else { const int si = it - N_PCH - N_ATT, sc = si >> 1, s = sc >> 3, h = sc & 7;
                hgrn_chain(REC, args.in[I_ST] + (size_t)sc * 16384, out + O_SS + (size_t)sc * 16384, MIX, 1024 + s * 2, 2, h, si & 1, lds, wave, lane); }
        }
    }
    SEAM(6);
    if (IN(7)) rec_norm_pass(Zb, args.in[I_HN], MIX, gw, NGW, lane);
    SEAM(7);
    if (IN(8)) { { pg8::Gemm g{MIX, WOUT, M, D, D}; pg8::StaticOrder S; S.init(M, D, G, bx); pg8::EpiBf16 E{Y, D};
        pg8::gemm_phase<pg8::EpiBf16, pg8::StaticOrder, true, true>(lds, g, S, E); }
        if (G == 256 ? bx >= 64 : true) { pg8::Gemm g{PB, WPP, M, D, PLE}; pg8::StaticOrder S; if (G == 256) S.init(M, D, 192, bx - 64); else S.init(M, D, G, bx); pg8::EpiBf16 E{U, D};
            pg8::gemm_phase<pg8::EpiBf16, pg8::StaticOrder, true, true>(lds, g, S, E); } }
    SEAM(8);
    if (IN(9)) norm_pass<true, true>(nullptr, nullptr, XB0, Y, args.in[I_MPOST], 1.0f, args.in[I_F2PRE], nullptr, XB0, XN, gw, NGW, lane);
    SEAM(9);
    if (IN(10)) { { pg8::Gemm g{XN, W2GU, M, 2 * FF, D}; pg8::StaticOrder S; S.wgm = 4; S.init(M, 2 * FF, G, bx); pg8::EpiSwiGLU E{H, FF};
        pg8::gemm_phase<pg8::EpiSwiGLU, pg8::StaticOrder, true, true>(lds, g, S, E); }
        if (bx >= 96) { LAS float* scr = (LAS float*)(lds + wave * 16384); constexpr int IT_BIG = 32 * 176, IT_SQ = 32 * 64;
            for (int it = (bx - 96) * NWAVES + wave; it < IT_BIG + IT_SQ; it += 160 * NWAVES) { int r = it;
                if (transpose_mat(r, args.in[I_F2D], FF, D, W2D, 0, scr, lane)) continue;
                transpose_mat(r, args.in[I_WPG], D, D, WPG, 0, scr, lane); } } }
    SEAM(10);
    if (IN(11)) {
        { pg8::Gemm g{H, W2D, M, D, FF}; pg8::RangeOrder<0, 4> S; S.init(M, D, G, bx); pg8::EpiBf16 E{Y, D};
          pg8::gemm_phase<pg8::EpiBf16, pg8::RangeOrder<0, 4>, true, true>(lds, g, S, E); }
        if (bx < 128) { const int hk = (bx & 1) * (FF / 2);
            pg8::Gemm g{H + hk, W2D + hk, M, D, FF / 2, FF}; pg8::RangeOrder<4, 5> S; S.init(M, D, G, bx >> 1); pg8::EpiF32Tile E{PART + (size_t)bx * 65536};
            pg8::gemm_phase<pg8::EpiF32Tile, pg8::RangeOrder<4, 5>, true, true>(lds, g, S, E); } }
    SEAM(11);
    if (IN(12)) norm_pass<true, true>(nullptr, nullptr, XB0, Y, args.in[I_F2POST], 0.5f, args.in[I_PPRE], nullptr, XB1, XN, gw, NGW, lane, PART);
    SEAM(12);
    if (IN(14)) { pg8::Gemm g{XN, WPG, M, D, D}; pg8::StaticOrder S; S.init(M, D, G, bx); pg8::EpiSigMul E{Y, U, D};
        pg8::gemm_phase<pg8::EpiSigMul, pg8::StaticOrder, true, true>(lds, g, S, E); }
    SEAM(14);
    if (IN(15)) norm_pass<true, false>(nullptr, nullptr, XB1, Y, args.in[I_PPOST], 1.0f, nullptr, out, nullptr, nullptr, gw, NGW, lane);
#undef IN
#undef SEAM
}

extern "C" void kernel_launch(void* const* d_in, const int* in_sizes, int n_in, void* d_out, int out_size, void* d_ws, size_t ws_size, hipStream_t stream) {
    static int grid = 0;
    if (grid == 0) {
        if (n_in != 29 || (size_t)out_size != O_END || ws_size < WS_END) { fprintf(stderr, "kernel_launch: unexpected sizes n_in %d out %d ws %zu\n", n_in, out_size, ws_size); grid = -1; return; }
        int dev = 0, cus = 0, per_cu = 0;
        hipGetDevice(&dev); hipDeviceGetAttribute(&cus, hipDeviceAttributeMultiprocessorCount, dev);
        if (hipFuncSetAttribute((const void*)hybrid_fwd, hipFuncAttributeMaxDynamicSharedMemorySize, LDS_BYTES) != hipSuccess) { fprintf(stderr, "kernel_launch: hipFuncSetAttribute failed\n"); grid = -1; return; }
        if (hipOccupancyMaxActiveBlocksPerMultiprocessor(&per_cu, (const void*)hybrid_fwd, NTHR, LDS_BYTES) != hipSuccess || per_cu < 1) per_cu = 1;
        (void)hipGetLastError();
        grid = cus * per_cu;
        if (grid != 256) { fprintf(stderr, "kernel_launch: this build needs a 256-workgroup grid (got %d)\n", grid); grid = -1; return; }
        fprintf(stderr, "kernel_launch: grid %d (cus %d x %d)\n", grid, cus, per_cu);
    }
    if (grid < 0) return;
    hipMemsetAsync((char*)d_ws + WS_CTL, 0, CTL_BYTES, stream);
    Args a{};
    for (int i = 0; i < 29; ++i) a.in[i] = (const float*)d_in[i];
    a.out = (float*)d_out; a.ws = (unsigned char*)d_ws; a.lo = 0; a.hi = NPHASE;
    void* kargs[] = {&a};
    hipError_t e = hipLaunchCooperativeKernel((const void*)hybrid_fwd, dim3(grid), dim3(NTHR), kargs, LDS_BYTES, stream);
    if (e != hipSuccess) fprintf(stderr, "kernel_launch: cooperative launch failed: %s (grid %d)\n", hipGetErrorString(e), grid);
}
```

```cpp
#include <hip/hip_runtime.h>
#include <hip/hip_cooperative_groups.h>
#include <cstdio>
#include <cstdint>
namespace cg = cooperative_groups;
namespace pg8 {
#define PG8_LAS __attribute__((address_space(3)))
typedef unsigned short bf16_t;
typedef short bf16x8 __attribute__((ext_vector_type(8)));
typedef float f32x4 __attribute__((ext_vector_type(4)));
typedef unsigned u32x4 __attribute__((ext_vector_type(4)));
constexpr int BM = 256, BK = 64, HALF = 128, HTB = HALF * BK * 2  , STAGE_BYTES = 8 * HTB, NXCD = 8, WGM = 8;

__host__ __device__ __forceinline__ int lds_byte(int r, int c) { const int st = (r >> 4) * 2 + (c >> 5), rr = r & 15, cc = c & 31, ob = rr * 64 + cc * 2; return st * 1024 + (ob ^ (((ob >> 9) & 1) << 5)); }
__host__ __device__ __forceinline__ void stage_rc(int b, int& R, int& C) { const int st = b / 1024, sb = b % 1024, swz = sb ^ (((sb >> 9) & 1) << 5); R = (st >> 1) * 16 + swz / 64; C = (st & 1) * 32 + (swz % 64) / 2; }
__host__ __device__ __forceinline__ int perm32(int rho) { const int n = rho >> 4, i = rho & 15; return 8 * (i >> 2) + 4 * n + (i & 3); }

struct Unit { int pm, pn; };
struct Gemm { const bf16_t* A; const bf16_t* Bt; int M, N, K; int ld = 0; };

struct StaticOrder {
    int nM, nN, nwg, G, c; int wgm = WGM;
    __host__ __device__ void init(int M, int N, int G_, int c_) { nM = M / BM; nN = N / BM; nwg = nM * nN; G = G_; c = c_; }
    __host__ __device__ bool next(int i, Unit& u) const {
        const long L = (long)i * G + c; if (L >= nwg) return false;
        int wgid = (int)L; { const int q = nwg / NXCD, r = nwg % NXCD, xcd = wgid % NXCD, off = wgid / NXCD; wgid = (xcd < r ? xcd * (q + 1) : r * (q + 1) + (xcd - r) * q) + off; }
        const int nig = wgm * nN, gid = wgid / nig, fm = gid * wgm, gsz = (nM - fm) < wgm ? (nM - fm) : wgm;
        u.pm = fm + ((wgid % nig) % gsz); u.pn = (wgid % nig) / gsz; return true;
    }
    __device__ __forceinline__ void a_ready(const Unit&) const {}
    __device__ __forceinline__ void done(const Unit&) const {}
};

template <int I0, int I1> struct RangeOrder : StaticOrder {
    __host__ __device__ bool next(int i, Unit& u) const { return (i + I0 < I1) && StaticOrder::next(i + I0, u); }
};
typedef __bf16 bf16x2_cv __attribute__((ext_vector_type(2)));
typedef float f32x2_cv __attribute__((ext_vector_type(2)));
__device__ __forceinline__ unsigned cvt_pk_bf16(float lo, float hi) { const f32x2_cv v = {lo, hi}; return __builtin_bit_cast(unsigned, __builtin_convertvector(v, bf16x2_cv)); }
__device__ __forceinline__ float bf_lo(unsigned u) { return __uint_as_float(u << 16); }
__device__ __forceinline__ float bf_hi(unsigned u) { return __uint_as_float(u & 0xffff0000u); }
__device__ __forceinline__ float sigmoidf_(float x) { return __builtin_amdgcn_rcpf(1.0f + __expf(-x)); }
__device__ __forceinline__ float siluf_(float x) { return x * sigmoidf_(x); }

struct EpiBf16 {
    static constexpr bool PERM = true, AFTER_DRAIN = false;
    bf16_t* O; int ldc; bool nt = false;
    __device__ __forceinline__ void operator()(const f32x4 (&acc)[2][2][4][2], const Unit& u, int wr, int wc, int fr, int fq) const {
        const int row0 = u.pm * BM + wr * 64 + fr, col0 = u.pn * BM + wc * 32 + 8 * fq;
#pragma unroll
        for (int ai = 0; ai < 2; ++ai)
#pragma unroll
            for (int m = 0; m < 4; ++m) { bf16_t* rowp = O + (size_t)(row0 + ai * HALF + m * 16) * ldc + col0;
#pragma unroll
                for (int bj = 0; bj < 2; ++bj) { const f32x4 v0 = acc[ai][bj][m][0], v1 = acc[ai][bj][m][1];
                    u32x4 w; w.x = cvt_pk_bf16(v0[0], v0[1]); w.y = cvt_pk_bf16(v0[2], v0[3]); w.z = cvt_pk_bf16(v1[0], v1[1]); w.w = cvt_pk_bf16(v1[2], v1[3]);
                    if (nt) __builtin_nontemporal_store(w, (u32x4*)(rowp + bj * HALF)); else *(u32x4*)(rowp + bj * HALF) = w; } }
    }
};
struct EpiF32Tile {
    static constexpr bool PERM = true, AFTER_DRAIN = false;
    float* P;
    __device__ __forceinline__ void operator()(const f32x4 (&acc)[2][2][4][2], const Unit&, int wr, int wc, int fr, int fq) const {
        const int row0 = wr * 64 + fr, col0 = wc * 32 + 8 * fq;
#pragma unroll
        for (int ai = 0; ai < 2; ++ai)
#pragma unroll
            for (int m = 0; m < 4; ++m) { float* rowp = P + (size_t)(row0 + ai * HALF + m * 16) * 256 + col0;
#pragma unroll
                for (int bj = 0; bj < 2; ++bj) { *(f32x4*)(rowp + bj * HALF) = acc[ai][bj][m][0]; *(f32x4*)(rowp + bj * HALF + 4) = acc[ai][bj][m][1]; } }
    }
};
struct EpiSwiGLU {
    static constexpr bool PERM = true, AFTER_DRAIN = false;
    bf16_t* O; int ldc;
    __device__ __forceinline__ void operator()(const f32x4 (&acc)[2][2][4][2], const Unit& u, int wr, int wc, int fr, int fq) const {
        const int row0 = u.pm * BM + wr * 64 + fr, col0 = u.pn * HALF + wc * 32 + 8 * fq;
#pragma unroll
        for (int ai = 0; ai < 2; ++ai)
#pragma unroll
            for (int m = 0; m < 4; ++m) { bf16_t* rowp = O + (size_t)(row0 + ai * HALF + m * 16) * ldc + col0;
                const f32x4 g0 = acc[ai][0][m][0], g1 = acc[ai][0][m][1], u0 = acc[ai][1][m][0], u1 = acc[ai][1][m][1];
                u32x4 w; w.x = cvt_pk_bf16(siluf_(g0[0]) * u0[0], siluf_(g0[1]) * u0[1]); w.y = cvt_pk_bf16(siluf_(g0[2]) * u0[2], siluf_(g0[3]) * u0[3]);
                w.z = cvt_pk_bf16(siluf_(g1[0]) * u1[0], siluf_(g1[1]) * u1[1]); w.w = cvt_pk_bf16(siluf_(g1[2]) * u1[2], siluf_(g1[3]) * u1[3]);
                __builtin_nontemporal_store(w, (u32x4*)rowp); }
    }
};
struct EpiSigMul {
    static constexpr bool PERM = true, AFTER_DRAIN = false;
    bf16_t* O; const bf16_t* U; int ldc;
    __device__ __forceinline__ void operator()(const f32x4 (&acc)[2][2][4][2], const Unit& u, int wr, int wc, int fr, int fq) const {
        const int row0 = u.pm * BM + wr * 64 + fr, col0 = u.pn * BM + wc * 32 + 8 * fq;
#pragma unroll
        for (int ai = 0; ai < 2; ++ai)
#pragma unroll
            for (int m = 0; m < 4; ++m) { const size_t off = (size_t)(row0 + ai * HALF + m * 16) * ldc + col0;
#pragma unroll
                for (int bj = 0; bj < 2; ++bj) { const f32x4 v0 = acc[ai][bj][m][0], v1 = acc[ai][bj][m][1];
                    const u32x4 uu = *(const u32x4*)(U + off + bj * HALF);
                    u32x4 w; w.x = cvt_pk_bf16(sigmoidf_(v0[0]) * bf_lo(uu.x), sigmoidf_(v0[1]) * bf_hi(uu.x)); w.y = cvt_pk_bf16(sigmoidf_(v0[2]) * bf_lo(uu.y), sigmoidf_(v0[3]) * bf_hi(uu.y));
                    w.z = cvt_pk_bf16(sigmoidf_(v1[0]) * bf_lo(uu.z), sigmoidf_(v1[1]) * bf_hi(uu.z)); w.w = cvt_pk_bf16(sigmoidf_(v1[2]) * bf_lo(uu.w), sigmoidf_(v1[3]) * bf_hi(uu.w));
                    *(u32x4*)(O + off + bj * HALF) = w; } }
    }
};
template <class Epi, class Sched, bool ALIGN_EPI = false, bool SP2 = false>
__device__ __forceinline__ void gemm_phase(PG8_LAS unsigned char* lds, const Gemm g, const Sched& S, const Epi& E) {
    const int tid = threadIdx.x, wid = __builtin_amdgcn_readfirstlane(tid >> 6), lane = tid & 63, wr = wid >> 2, wc = wid & 3, fr = lane & 15, fq = lane >> 4;
    const int K = g.K, nt = K / BK, LD = g.ld ? g.ld : g.K;
    unsigned voffA[2], voffB[2];
#pragma unroll
    for (int i = 0; i < 2; ++i) { int R, C; stage_rc(tid * 16 + i * 8192, R, C); const int Rb = Epi::PERM ? ((R & ~31) + perm32(R & 31)) : R;
        voffA[i] = (unsigned)(R * LD + C) * 2u; voffB[i] = (unsigned)(Rb * LD + C) * 2u; }
    const size_t kstep = (size_t)(BK * 2);
    const size_t hstep = (size_t)HALF * LD * 2;
    const size_t tstep = 2 * hstep;
    const unsigned ldsw = (unsigned)wid * 1024u;
    const int aoff = lds_byte(wr * 64 + fr, fq * 8), boff = lds_byte(wc * 32 + fr, fq * 8);
#define PG8_SA(b, h) (((b) * 2 + (h)) * HTB)
#define PG8_SB(b, h) ((4 + (b) * 2 + (h)) * HTB)
#define PG8_STAGE(bufoff, gbase, voff) do { _Pragma("unroll") for (int _i = 0; _i < 2; ++_i) \
        __builtin_amdgcn_global_load_lds((const unsigned*)((const char*)(gbase) + (voff)[_i]), (PG8_LAS unsigned*)(lds + (bufoff) + ldsw + _i * 8192), 16, 0, 0); } while (0)
#define PG8_LDA(dst, b, h) do { _Pragma("unroll") for (int m = 0; m < 4; ++m) _Pragma("unroll") for (int k = 0; k < 2; ++k) dst[m][k] = *(const PG8_LAS bf16x8*)(lds + PG8_SA(b, h) + aoff + m * 2048 + k * 1024); } while (0)
#define PG8_LDB(dst, b, h) do { _Pragma("unroll") for (int n = 0; n < 2; ++n) _Pragma("unroll") for (int k = 0; k < 2; ++k) dst[n][k] = *(const PG8_LAS bf16x8*)(lds + PG8_SB(b, h) + boff + n * 2048 + k * 1024); } while (0)
#define PG8_MMA(ai, bj, At, Bt) do { __builtin_amdgcn_s_setprio(1); _Pragma("unroll") for (int m = 0; m < 4; ++m) _Pragma("unroll") for (int n = 0; n < 2; ++n) _Pragma("unroll") for (int k = 0; k < 2; ++k) \
        acc[ai][bj][m][n] = __builtin_amdgcn_mfma_f32_16x16x32_bf16(Bt[n][k], At[m][k], acc[ai][bj][m][n], 0, 0, 0); __builtin_amdgcn_s_setprio(0); } while (0)
#define PG8_WAIT_V(n) asm volatile("s_waitcnt vmcnt(" #n ")" ::: "memory")
#define PG8_WAIT_L(n) asm volatile("s_waitcnt lgkmcnt(" #n ")" ::: "memory")
#define PG8_BAR __builtin_amdgcn_s_barrier()
#define PG8_SCHED __builtin_amdgcn_sched_barrier(0)
    Unit cur, nxt; int ui = 0;
    if (!S.next(0, cur)) return;
    f32x4 acc[2][2][4][2];
#pragma unroll
    for (int a = 0; a < 2; ++a)
#pragma unroll
        for (int b = 0; b < 2; ++b)
#pragma unroll
            for (int m = 0; m < 4; ++m)
#pragma unroll
                for (int n = 0; n < 2; ++n) acc[a][b][m][n] = (f32x4){0.f, 0.f, 0.f, 0.f};
    bf16x8 At[4][2], B0[2][2], B1[2][2];
    const char* cA = (const char*)g.A + (size_t)cur.pm * tstep; const char* cB = (const char*)g.Bt + (size_t)cur.pn * tstep;
    S.a_ready(cur);
    if constexpr (SP2) {
        PG8_STAGE(PG8_SB(0, 0), cB, voffB); PG8_STAGE(PG8_SB(0, 1), cB + hstep, voffB); PG8_STAGE(PG8_SA(0, 0), cA, voffA); PG8_STAGE(PG8_SA(0, 1), cA + hstep, voffA);
        if (wr == 1) PG8_BAR;
        PG8_WAIT_V(2); PG8_BAR;
        PG8_STAGE(PG8_SB(1, 0), cB + kstep, voffB); PG8_STAGE(PG8_SA(1, 0), cA + kstep, voffA); PG8_STAGE(PG8_SB(1, 1), cB + hstep + kstep, voffB);
        PG8_WAIT_V(6); PG8_BAR;
    } else {
        PG8_STAGE(PG8_SB(0, 0), cB, voffB); PG8_STAGE(PG8_SA(0, 0), cA, voffA); PG8_STAGE(PG8_SB(0, 1), cB + hstep, voffB); PG8_STAGE(PG8_SA(0, 1), cA + hstep, voffA);
        if (wr == 1) PG8_BAR;
        PG8_WAIT_V(4); PG8_BAR;
        PG8_STAGE(PG8_SB(1, 0), cB + kstep, voffB); PG8_STAGE(PG8_SA(1, 0), cA + kstep, voffA); PG8_STAGE(PG8_SB(1, 1), cB + hstep + kstep, voffB);
        PG8_WAIT_V(6); PG8_BAR;
    }
    for (;;) {
        const bool has_next = S.next(ui + 1, nxt);
        const char* nA = has_next ? (const char*)g.A + (size_t)nxt.pm * tstep : cA; const char* nB = has_next ? (const char*)g.Bt + (size_t)nxt.pn * tstep : cB;
        for (int t = 0; t < nt; t += 2) {
            const bool last = (t == nt - 2);
            const char* a1 = cA + (size_t)(t + 1) * kstep;
            const char* a2 = last ? nA : cA + (size_t)(t + 2) * kstep; const char* b2 = last ? nB : cB + (size_t)(t + 2) * kstep;
            const char* a3 = a2 + kstep; const char* b3 = b2 + kstep;
            if (last && has_next) S.a_ready(nxt);
            if constexpr (SP2) {
            PG8_LDB(B0, 0, 0); PG8_LDB(B1, 0, 1); PG8_SCHED; PG8_LDA(At, 0, 0); PG8_STAGE(PG8_SA(1, 1), a1 + hstep, voffA);
            PG8_WAIT_V(8); PG8_WAIT_L(0); PG8_BAR; PG8_MMA(0, 0, At, B0); PG8_MMA(0, 1, At, B1); PG8_BAR; PG8_SCHED;
            PG8_LDA(At, 0, 1); PG8_STAGE(PG8_SB(0, 0), b2, voffB); PG8_STAGE(PG8_SB(0, 1), b2 + hstep, voffB); PG8_STAGE(PG8_SA(0, 0), a2, voffA);
            PG8_WAIT_V(8); PG8_WAIT_L(0); PG8_BAR; PG8_MMA(1, 0, At, B0); PG8_MMA(1, 1, At, B1); PG8_BAR; PG8_SCHED;
            PG8_LDB(B0, 1, 0); PG8_LDB(B1, 1, 1); PG8_SCHED; PG8_LDA(At, 1, 0); PG8_STAGE(PG8_SA(0, 1), a2 + hstep, voffA);
            PG8_WAIT_V(8); PG8_WAIT_L(0); PG8_BAR; PG8_MMA(0, 0, At, B0); PG8_MMA(0, 1, At, B1); PG8_BAR; PG8_SCHED;
            PG8_LDA(At, 1, 1); PG8_STAGE(PG8_SB(1, 0), b3, voffB); PG8_STAGE(PG8_SB(1, 1), b3 + hstep, voffB); PG8_STAGE(PG8_SA(1, 0), a3, voffA);
            PG8_WAIT_V(8); PG8_WAIT_L(0); PG8_BAR; PG8_MMA(1, 0, At, B0); PG8_MMA(1, 1, At, B1); PG8_BAR; PG8_SCHED;
            } else {
            PG8_LDB(B0, 0, 0); PG8_SCHED; PG8_LDA(At, 0, 0); PG8_STAGE(PG8_SA(1, 1), a1 + hstep, voffA);
            PG8_WAIT_L(8); PG8_BAR; PG8_WAIT_L(0); PG8_MMA(0, 0, At, B0); PG8_BAR; PG8_SCHED;
            PG8_LDB(B1, 0, 1); PG8_STAGE(PG8_SB(0, 0), b2, voffB);
            PG8_BAR; PG8_WAIT_L(0); PG8_MMA(0, 1, At, B1); PG8_BAR;
            PG8_LDA(At, 0, 1); PG8_STAGE(PG8_SA(0, 0), a2, voffA);
            PG8_BAR; PG8_WAIT_L(0); PG8_MMA(1, 0, At, B0); PG8_BAR; PG8_SCHED;
            PG8_STAGE(PG8_SB(0, 1), b2 + hstep, voffB);
            PG8_WAIT_V(6); PG8_BAR; PG8_MMA(1, 1, At, B1); PG8_BAR;
            PG8_LDB(B0, 1, 0); PG8_SCHED; PG8_LDA(At, 1, 0); PG8_STAGE(PG8_SA(0, 1), a2 + hstep, voffA);
            PG8_WAIT_L(8); PG8_BAR; PG8_WAIT_L(0); PG8_MMA(0, 0, At, B0); PG8_BAR; PG8_SCHED;
            PG8_LDB(B1, 1, 1); PG8_STAGE(PG8_SB(1, 0), b3, voffB);
            PG8_BAR; PG8_WAIT_L(0); PG8_MMA(0, 1, At, B1); PG8_BAR;
            PG8_LDA(At, 1, 1); PG8_STAGE(PG8_SA(1, 0), a3, voffA);
            PG8_BAR; PG8_WAIT_L(0); PG8_MMA(1, 0, At, B0); PG8_BAR; PG8_SCHED;
            PG8_STAGE(PG8_SB(1, 1), b3 + hstep, voffB);
            PG8_WAIT_V(6); PG8_BAR; PG8_MMA(1, 1, At, B1); PG8_BAR;
            }
        }
        if constexpr (ALIGN_EPI) { if (wr == 0) PG8_BAR; }
        if constexpr (!Epi::AFTER_DRAIN) { E(acc, cur, wr, wc, fr, fq); S.done(cur); }
        if (!has_next) break;
#pragma unroll
        for (int a = 0; a < 2; ++a)
#pragma unroll
            for (int b = 0; b < 2; ++b)
#pragma unroll
                for (int m = 0; m < 4; ++m)
#pragma unroll
                    for (int n = 0; n < 2; ++n) acc[a][b][m][n] = (f32x4){0.f, 0.f, 0.f, 0.f};
        cur = nxt; cA = nA; cB = nB; ++ui;
        if constexpr (ALIGN_EPI) { if (wr == 1) PG8_BAR; }
    }
    PG8_WAIT_V(0);
    if constexpr (!ALIGN_EPI) { if (wr == 0) PG8_BAR; }
    PG8_BAR;
    if constexpr (Epi::AFTER_DRAIN) { E.fused(acc, cur, wr, wc, fr, fq, lds, wid, lane); S.done(cur); }
#undef PG8_SA
#undef PG8_SB
#undef PG8_STAGE
#undef PG8_LDA
#undef PG8_LDB
#undef PG8_MMA
#undef PG8_WAIT_V
#undef PG8_WAIT_L
#undef PG8_BAR
#undef PG8_SCHED
}
}
#define LAS __attribute__((address_space(3)))
using pg8::bf16_t; using pg8::bf16x8; using pg8::f32x4; using pg8::u32x4; using pg8::cvt_pk_bf16; using pg8::bf_lo; using pg8::bf_hi; using pg8::sigmoidf_; using pg8::siluf_;
typedef unsigned u32x2 __attribute__((ext_vector_type(2)));
constexpr int NWAVES = 8, NTHR = 512;
constexpr int MP = 32768, MS = 2048, M = MP + MS, D = 2048, FF = 5632, DIN = 5632, PLE = 256;
constexpr int ZQ = 0, ZK = 1024, ZV = 1280, ZHQ = 1536, ZHF = 2560, ZHI = 3584, ZHG = 4608;
constexpr float EPS = 1e-6f;
constexpr size_t MiB = 1u << 20;
constexpr size_t WS_CTL = 0, CTL_BYTES = 65536;
constexpr size_t WS_W1GU = 1 * MiB, WS_W1D = WS_W1GU + 44 * MiB, WS_WIN = WS_W1D + 22 * MiB, WS_WOUT = WS_WIN + 22 * MiB, WS_W2GU = WS_WOUT + 8 * MiB, WS_W2D = WS_W2GU + 44 * MiB,
                 WS_WPG = WS_W2D + 22 * MiB, WS_WPP = WS_WPG + 8 * MiB, WS_BTAB = WS_WPP + 1 * MiB;
constexpr size_t WS_XN = WS_BTAB + 1 * MiB;
constexpr size_t WS_H = WS_XN + 136 * MiB;
constexpr size_t WS_Y = WS_H + 374 * MiB;
constexpr size_t REC_STRIDE = 27136, NREC = (size_t)(M / 32) * 8;
constexpr size_t WS_U = WS_Y + 136 * MiB;
constexpr size_t WS_PART = WS_U + 136 * MiB;
constexpr size_t WS_PB = 1007 * MiB;
constexpr size_t WS_END = WS_PB + 17 * MiB;
static_assert(WS_PART + 32 * MiB <= WS_PB && WS_U + 136 * MiB <= WS_PB && WS_Y + 228 * MiB <= WS_PB, "ws map 2");
static_assert(NREC * REC_STRIDE + 1024 <= 228 * MiB && WS_END <= 1024 * MiB, "ws map");
constexpr int R_QD = 0, R_KE = 8192, R_IT = 16384, R_A = 24576, R_DEC = 26624;
constexpr size_t O_KP = (size_t)M * D, O_VP = O_KP + 131072, O_SP = O_VP + 131072, O_KS = O_SP + 524288, O_VS = O_KS + 1048576, O_SS = O_VS + 1048576, O_END = O_SS + 4194304;
constexpr int LDS_BYTES = 147456;
constexpr int CW_QUEUE = 0, CW_BAR = 1024;

struct Args { const float* in[29]; float* out; unsigned char* ws; int lo, hi; };
enum { I_XP = 0, I_XS, I_CK, I_CV, I_ST, I_PP, I_PS, I_TAB, I_F1PRE, I_F1POST, I_F1G, I_F1U, I_F1D, I_MPRE, I_MPOST, I_WIN, I_WOUT, I_SINK, I_LB, I_HN, I_F2PRE, I_F2POST, I_F2G, I_F2U, I_F2D, I_PPRE, I_PPOST, I_WPG, I_WPP };

__device__ __forceinline__ float wave_sum(float v) {
#pragma unroll
    for (int o = 1; o < 64; o <<= 1) v += __shfl_xor(v, o);
    return v;
}
#define LDS_WAIT() asm volatile("s_waitcnt lgkmcnt(0)" ::: "memory")

__device__ __forceinline__ void transpose_item(const float* W, int K, int N, bf16_t* WT, int k0, int n0, int drow0, LAS float* scr, int lane) {
    asm volatile("" : "+v"(lane)); __builtin_assume(lane >= 0 && lane < 64);
#pragma unroll 8
    for (int i = 0; i < 32; ++i) { const int kk = 2 * i + (lane >> 5); scr[kk * 33 + (lane & 31)] = __builtin_nontemporal_load(&W[(size_t)(k0 + kk) * N + n0 + (lane & 31)]); }
    LDS_WAIT();
    const int c = lane & 7;
#pragma unroll
    for (int j = 0; j < 4; ++j) { const int n = (lane >> 3) + 8 * j; const LAS float* s = scr + (8 * c) * 33 + n;
        u32x4 o; o.x = cvt_pk_bf16(s[0 * 33], s[1 * 33]); o.y = cvt_pk_bf16(s[2 * 33], s[3 * 33]); o.z = cvt_pk_bf16(s[4 * 33], s[5 * 33]); o.w = cvt_pk_bf16(s[6 * 33], s[7 * 33]);
        *(u32x4*)(WT + (size_t)(drow0 + n) * K + k0 + 8 * c) = o; }
    LDS_WAIT();
}
__device__ __forceinline__ bool transpose_mat(int& r, const float* W, int K, int N, bf16_t* WT, int mode, LAS float* scr, int lane) {
    const int nblk = N / 32, items = (K / 64) * nblk;
    if (r >= items) { r -= items; return false; }
    const int kb = r / nblk, nb = r % nblk, n0 = 32 * nb;
    const int drow0 = mode == 0 ? n0 : (n0 / 128) * 256 + (n0 % 128) + (mode == 2 ? 128 : 0);
    transpose_item(W, K, N, WT, 64 * kb, n0, drow0, scr, lane);
    return true;
}
__device__ __forceinline__ void rms_row_to_bf16(const f32x4 (&v)[8], const float* gain, bf16_t* orow, int lane) {
    const f32x4* gr = (const f32x4*)gain + lane;
    float s = 0.f;
#pragma unroll
    for (int j = 0; j < 8; ++j) s += (v[j].x * v[j].x + v[j].y * v[j].y) + (v[j].z * v[j].z + v[j].w * v[j].w);
    const float rstd = rsqrtf(wave_sum(s) * (1.f / D) + EPS);
    u32x2* o8 = (u32x2*)orow + lane;
#pragma unroll
    for (int j = 0; j < 8; ++j) { const f32x4 g = gr[64 * j]; u32x2 w; w.x = cvt_pk_bf16(v[j].x * rstd * g.x, v[j].y * rstd * g.y); w.y = cvt_pk_bf16(v[j].z * rstd * g.z, v[j].w * rstd * g.w); o8[64 * j] = w; }
}
__device__ __forceinline__ void norm_load_y(const bf16_t* Y, const float* PART, int m, int lane, u32x2 (&y)[8]) {
    const u32x2* yr = (const u32x2*)(Y + (size_t)m * D) + lane;
#pragma unroll
    for (int j = 0; j < 8; ++j) y[j] = __builtin_nontemporal_load(&yr[64 * j]);
    const int pm = m >> 8, q = pm - 16;
    if (PART && q >= 0 && (q & 15) < 8) {
        const int pn = q >> 4, c = (q & 15) * 8 + pn;
        const float* pa = PART + ((size_t)(2 * c) * 256 + (m & 255)) * 256 + 4 * lane;
        const f32x4 a = *(const f32x4*)pa, b = *(const f32x4*)(pa + 65536);
        u32x2 w; w.x = cvt_pk_bf16(a.x + b.x, a.y + b.y); w.y = cvt_pk_bf16(a.z + b.z, a.w + b.w);
#pragma unroll
        for (int j = 0; j < 8; ++j) if (j == pn) y[j] = w;
    }
}
template <bool XIN_BF, bool XOUT_BF>
__device__ __forceinline__ void norm_load_x(const float* xp, const float* xs, const bf16_t* xb, int m, int lane, f32x4 (&v)[8]) {
    if (XIN_BF) { const u32x2* xr = (const u32x2*)(xb + (size_t)m * D) + lane;
#pragma unroll
        for (int j = 0; j < 8; ++j) { const u32x2 w = __builtin_nontemporal_load(&xr[64 * j]); v[j] = (f32x4){bf_lo(w.x), bf_hi(w.x), bf_lo(w.y), bf_hi(w.y)}; }
    } else { const float* xrow = (m < MP) ? xp + (size_t)m * D : xs + (size_t)(m - MP) * D; const f32x4* xr = (const f32x4*)xrow + lane;
#pragma unroll
        for (int j = 0; j < 8; ++j) v[j] = __builtin_nontemporal_load(&xr[64 * j]); }
}
template <bool XIN_BF, bool XOUT_BF>
__device__ __forceinline__ void norm_pass(const float* xp, const float* xs, const bf16_t* xbin, const bf16_t* Y, const float* post, float scale, const float* pre, float* X, bf16_t* xbout, bf16_t* XN, int gw, int NGW, int lane, const float* PART = nullptr) {
    f32x4 v[8]; u32x2 y[8];
    norm_load_x<XIN_BF, XOUT_BF>(xp, xs, xbin, gw, lane, v); norm_load_y(Y, PART, gw, lane, y);
    for (int m = gw; m < M; m += NGW) {
        f32x4 vn[8]; u32x2 yn[8];
        const int mn = m + NGW < M ? m + NGW : m;
        norm_load_x<XIN_BF, XOUT_BF>(xp, xs, xbin, mn, lane, vn); norm_load_y(Y, PART, mn, lane, yn);
        float s = 0.f;
#pragma unroll
        for (int j = 0; j < 8; ++j) { const float a = bf_lo(y[j].x), b = bf_hi(y[j].x), c = bf_lo(y[j].y), d = bf_hi(y[j].y); s += (a * a + b * b) + (c * c + d * d); }
        const float rs = rsqrtf(wave_sum(s) * (1.f / D) + EPS) * scale; float s2 = 0.f;
#pragma unroll
        for (int j = 0; j < 8; ++j) { const f32x4 g = ((const f32x4*)post + lane)[64 * j];
            v[j].x += bf_lo(y[j].x) * rs * g.x; v[j].y += bf_hi(y[j].x) * rs * g.y; v[j].z += bf_lo(y[j].y) * rs * g.z; v[j].w += bf_hi(y[j].y) * rs * g.w;
            s2 += (v[j].x * v[j].x + v[j].y * v[j].y) + (v[j].z * v[j].z + v[j].w * v[j].w);
            if (XOUT_BF) { u32x2 w; w.x = cvt_pk_bf16(v[j].x, v[j].y); w.y = cvt_pk_bf16(v[j].z, v[j].w); __builtin_nontemporal_store(w, &((u32x2*)(xbout + (size_t)m * D) + lane)[64 * j]); }
            else __builtin_nontemporal_store(v[j], &((f32x4*)(X + (size_t)m * D) + lane)[64 * j]); }
        if (pre) {
            const float r2 = rsqrtf(wave_sum(s2) * (1.f / D) + EPS); u32x2* o8 = (u32x2*)(XN + (size_t)m * D) + lane;
#pragma unroll
            for (int j = 0; j < 8; ++j) { const f32x4 g = ((const f32x4*)pre + lane)[64 * j]; u32x2 w; w.x = cvt_pk_bf16(v[j].x * r2 * g.x, v[j].y * r2 * g.y); w.y = cvt_pk_bf16(v[j].z * r2 * g.z, v[j].w * r2 * g.w); o8[64 * j] = w; }
        }
#pragma unroll
        for (int j = 0; j < 8; ++j) { v[j] = vn[j]; y[j] = yn[j]; }
    }
}
constexpr int PREP_WSTRIDE = 2 * 32 * 132 * 2;
typedef short bf16x4 __attribute__((ext_vector_type(4)));
__device__ __forceinline__ void hgrn_prep_item(const bf16_t* Z, const float* lbl, unsigned char* REC, int cidx, int h, LAS unsigned char* wl, int lane) {
    asm volatile("" : "+v"(lane)); __builtin_assume(lane >= 0 && lane < 64);
    LAS bf16_t* Xs = (LAS bf16_t*)wl; LAS bf16_t* Ys = Xs + 32 * 132;
    const int k0 = 2 * lane, m0 = cidx * 32, c16 = lane & 15, g = lane >> 4;
    float lb[2], omlb[2], cum[2] = {0.f, 0.f};
#pragma unroll
    for (int e = 0; e < 2; ++e) { const float l0 = lbl[h * 128 + k0 + e], l1 = lbl[1024 + h * 128 + k0 + e]; lb[e] = __builtin_amdgcn_rcpf(1.f + __expf(l1 - l0)); omlb[e] = 1.f - lb[e]; }
    float cv[32][2]; unsigned omp[32], qraw[32], itp[2][16];
    const bf16_t* zr = Z + (size_t)m0 * DIN + h * 128 + k0;
#pragma unroll
    for (int t = 0; t < 32; ++t) {
        const unsigned ff = *(const unsigned*)(zr + (size_t)t * DIN + ZHF), ii = *(const unsigned*)(zr + (size_t)t * DIN + ZHI);
        qraw[t] = *(const unsigned*)(zr + (size_t)t * DIN + ZHQ); float omv[2];
#pragma unroll
        for (int e = 0; e < 2; ++e) {
            const float fl = e ? bf_hi(ff) : bf_lo(ff);
            const float ex = __expf(-fl), sg = __builtin_amdgcn_rcpf(1.f + ex);
            const float f = lb[e] + omlb[e] * sg;
            omv[e] = omlb[e] * (ex * sg);
            cum[e] += __logf(f); cv[t][e] = cum[e];
        }
        omp[t] = cvt_pk_bf16(omv[0], omv[1]);
        if ((t & 1) == 0) { itp[0][t >> 1] = ii & 0xffffu; itp[1][t >> 1] = ii >> 16; }
        else { itp[0][t >> 1] |= ii << 16; itp[1][t >> 1] |= ii & 0xffff0000u; }
        if ((t & 15) == 15) asm volatile("" ::: "memory");
    }
    unsigned char* R = REC + ((size_t)cidx * 8 + h) * REC_STRIDE;
    {   u32x4* it = (u32x4*)(R + R_IT + k0 * 64);
#pragma unroll
        for (int e = 0; e < 2; ++e)
#pragma unroll
            for (int q4 = 0; q4 < 4; ++q4) it[4 * e + q4] = (u32x4){itp[e][4 * q4], itp[e][4 * q4 + 1], itp[e][4 * q4 + 2], itp[e][4 * q4 + 3]}; }
#pragma unroll
    for (int t = 0; t < 32; ++t) {
        const float q0 = bf_lo(qraw[t]), q1 = bf_hi(qraw[t]);
        *(LAS unsigned*)(Xs + t * 132 + k0) = cvt_pk_bf16(q0 * __expf(cv[t][0]), q1 * __expf(cv[t][1]));
        *(LAS unsigned*)(Ys + t * 132 + k0) = cvt_pk_bf16(bf_lo(omp[t]) * __expf(cv[15][0] - cv[t][0]), bf_hi(omp[t]) * __expf(cv[15][1] - cv[t][1]));
    }
    {
        u32x4* ke = (u32x4*)(R + R_KE + k0 * 64);
#pragma unroll
        for (int e = 0; e < 2; ++e) {
            unsigned kep[16];
#pragma unroll
            for (int t2 = 0; t2 < 16; ++t2) kep[t2] = cvt_pk_bf16((e ? bf_hi(omp[2 * t2]) : bf_lo(omp[2 * t2])) * __expf(cum[e] - cv[2 * t2][e]), (e ? bf_hi(omp[2 * t2 + 1]) : bf_lo(omp[2 * t2 + 1])) * __expf(cum[e] - cv[2 * t2 + 1][e]));
#pragma unroll
            for (int q4 = 0; q4 < 4; ++q4) { ke[4 * e + q4] = (u32x4){kep[4 * q4], kep[4 * q4 + 1], kep[4 * q4 + 2], kep[4 * q4 + 3]}; }
        }
        float2 dd; dd.x = __expf(cum[0]); dd.y = __expf(cum[1]); *(float2*)(R + R_DEC + k0 * 4) = dd;
    }
    LDS_WAIT();
#pragma unroll
    for (int tb = 0; tb < 2; ++tb)
#pragma unroll
        for (int kk = 0; kk < 4; ++kk) {
            const u32x2 lo = *(const LAS u32x2*)(Xs + (16 * tb + c16) * 132 + 32 * kk + 4 * g), hi = *(const LAS u32x2*)(Xs + (16 * tb + c16) * 132 + 32 * kk + 16 + 4 * g);
            *(u32x4*)(R + R_QD + ((tb * 4 + kk) * 64 + lane) * 16) = (u32x4){lo.x, lo.y, hi.x, hi.y};
        }
    LDS_WAIT();
#pragma unroll
    for (int t = 0; t < 32; ++t) {
        const float q0 = bf_lo(qraw[t]), q1 = bf_hi(qraw[t]);
        *(LAS unsigned*)(Xs + t * 132 + k0) = cvt_pk_bf16(q0 * __expf(cv[t][0] - cv[15][0]), q1 * __expf(cv[t][1] - cv[15][1]));
    }
    LDS_WAIT();
    f32x4 a00 = {0.f, 0.f, 0.f, 0.f}, a10 = a00, a11 = a00;
#pragma unroll
    for (int kk = 0; kk < 4; ++kk) {
        bf16x8 qf[2], kf[2];
#pragma unroll
        for (int b = 0; b < 2; ++b) {
            const u32x2 qlo = *(const LAS u32x2*)(Xs + (16 * b + c16) * 132 + 32 * kk + 4 * g), qhi = *(const LAS u32x2*)(Xs + (16 * b + c16) * 132 + 32 * kk + 16 + 4 * g);
            const u32x2 klo = *(const LAS u32x2*)(Ys + (16 * b + c16) * 132 + 32 * kk + 4 * g), khi = *(const LAS u32x2*)(Ys + (16 * b + c16) * 132 + 32 * kk + 16 + 4 * g);
            qf[b] = __builtin_bit_cast(bf16x8, ((u32x4){qlo.x, qlo.y, qhi.x, qhi.y})); kf[b] = __builtin_bit_cast(bf16x8, ((u32x4){klo.x, klo.y, khi.x, khi.y}));
        }
        a00 = __builtin_amdgcn_mfma_f32_16x16x32_bf16(kf[0], qf[0], a00, 0, 0, 0);
        a10 = __builtin_amdgcn_mfma_f32_16x16x32_bf16(kf[0], qf[1], a10, 0, 0, 0);
        a11 = __builtin_amdgcn_mfma_f32_16x16x32_bf16(kf[1], qf[1], a11, 0, 0, 0);
    }
#pragma unroll
    for (int i = 0; i < 4; ++i) if (4 * g + i > c16) { a00[i] = 0.f; a11[i] = 0.f; }
    u32x2 w;
    w.x = cvt_pk_bf16(a00[0], a00[1]); w.y = cvt_pk_bf16(a00[2], a00[3]); *(u32x2*)(R + R_A + (c16 * 32 + 4 * g) * 2) = w;
    w.x = 0u; w.y = 0u; *(u32x2*)(R + R_A + (c16 * 32 + 16 + 4 * g) * 2) = w;
    w.x = cvt_pk_bf16(a10[0], a10[1]); w.y = cvt_pk_bf16(a10[2], a10[3]); *(u32x2*)(R + R_A + ((16 + c16) * 32 + 4 * g) * 2) = w;
    w.x = cvt_pk_bf16(a11[0], a11[1]); w.y = cvt_pk_bf16(a11[2], a11[3]); *(u32x2*)(R + R_A + ((16 + c16) * 32 + 16 + 4 * g) * 2) = w;
    LDS_WAIT();
}

constexpr int CH_NS = 4, CH_SLOT = 27648;
static_assert(CH_NS * CH_SLOT <= 131072, "chain LDS");
#define CH_RAWBAR() do { asm volatile("s_waitcnt lgkmcnt(0)" ::: "memory"); __builtin_amdgcn_s_barrier(); asm volatile("" ::: "memory"); } while (0)
__device__ __forceinline__ void ch_issue(const unsigned char* Rl, LAS unsigned char* dst, int wave) {
    __builtin_amdgcn_global_load_lds((const unsigned*)(Rl + wave * 1024), (LAS unsigned*)(dst + wave * 1024), 16, 0, 0);
    __builtin_amdgcn_global_load_lds((const unsigned*)(Rl + (wave + 8) * 1024), (LAS unsigned*)(dst + (wave + 8) * 1024), 16, 0, 0);
    __builtin_amdgcn_global_load_lds((const unsigned*)(Rl + (wave + 16) * 1024), (LAS unsigned*)(dst + (wave + 16) * 1024), 16, 0, 0);
    if (wave < 3) __builtin_amdgcn_global_load_lds((const unsigned*)(Rl + (wave + 24) * 1024), (LAS unsigned*)(dst + (wave + 24) * 1024), 16, 0, 0);
}
#define CH_WAITN(N) asm volatile("s_waitcnt vmcnt(%0)" :: "n"(N) : "memory")
#define CH_WAIT(EX) do { if (wave < 3) CH_WAITN(8 + (EX)); else if (wave == 3) CH_WAITN(6 + (EX)); else CH_WAITN(6); } while (0)
__device__ __forceinline__ void hgrn_chain(const unsigned char* REC, const float* s0, float* sout, bf16_t* MIX,
                                           int cidx0, int nchunks, int h, int vhalf, LAS unsigned char* lds, int wave, int lane) {
    asm volatile("" : "+v"(lane)); __builtin_assume(lane >= 0 && lane < 64);
    const int c16 = lane & 15, g = lane >> 4, v0 = 64 * vhalf + 16 * (wave & 3);
    const bool comp = wave < 4;
    f32x4 S[8];
#pragma unroll
    for (int kb = 0; kb < 8; ++kb)
#pragma unroll
        for (int i = 0; i < 4; ++i) S[kb][i] = (s0 && comp) ? s0[(size_t)(16 * kb + 4 * g + i) * 128 + v0 + c16] : 0.f;
    bf16_t* mo = MIX + (size_t)(cidx0 * 32 + c16) * D + 1024 + h * 128 + v0 + 4 * g;
    const unsigned char* Rl = REC + ((size_t)cidx0 * 8 + h) * REC_STRIDE + lane * 16;
    const unsigned char* Rlast = Rl + (size_t)(nchunks - 1) * 8 * REC_STRIDE;
    asm volatile("s_waitcnt vmcnt(0)" ::: "memory");
    const unsigned char* Ri = Rl;
#pragma unroll
    for (int cc = 0; cc < CH_NS - 1; ++cc) { ch_issue(Ri, lds + cc * CH_SLOT, wave); Ri = Ri < Rlast ? Ri + 8 * REC_STRIDE : Rlast; }
    CH_WAIT(0);
    CH_RAWBAR();
    int slot = 0, islot = CH_NS - 1;
    for (int c = 0; c < nchunks; ++c) {
        ch_issue(Ri, lds + islot * CH_SLOT, wave); Ri = Ri < Rlast ? Ri + 8 * REC_STRIDE : Rlast;
        islot = islot == CH_NS - 1 ? 0 : islot + 1;
        const LAS unsigned char* R = lds + slot * CH_SLOT;
        slot = slot == CH_NS - 1 ? 0 : slot + 1;
        if (comp) {
            bf16x8 QDf[2][4], KEf[8], ITf, Af[2]; f32x4 DEC[8];
#pragma unroll
            for (int kb = 0; kb < 8; ++kb) { DEC[kb] = *(const LAS f32x4*)(R + R_DEC + (16 * kb + 4 * g) * 4); KEf[kb] = *(const LAS bf16x8*)(R + R_KE + ((16 * kb + c16) * 32 + 8 * g) * 2); }
            ITf = *(const LAS bf16x8*)(R + R_IT + ((v0 + c16) * 32 + 8 * g) * 2);
#pragma unroll
            for (int tb = 0; tb < 2; ++tb) {
                Af[tb] = *(const LAS bf16x8*)(R + R_A + ((16 * tb + c16) * 32 + 8 * g) * 2);
#pragma unroll
                for (int kk = 0; kk < 4; ++kk) QDf[tb][kk] = *(const LAS bf16x8*)(R + R_QD + ((tb * 4 + kk) * 64 + lane) * 16);
            }
            bf16x8 Sb[4];
#pragma unroll
            for (int kk = 0; kk < 4; ++kk) {
                u32x4 sb; sb.x = cvt_pk_bf16(S[2 * kk][0], S[2 * kk][1]); sb.y = cvt_pk_bf16(S[2 * kk][2], S[2 * kk][3]);
                sb.z = cvt_pk_bf16(S[2 * kk + 1][0], S[2 * kk + 1][1]); sb.w = cvt_pk_bf16(S[2 * kk + 1][2], S[2 * kk + 1][3]);
                Sb[kk] = __builtin_bit_cast(bf16x8, sb);
            }
#pragma unroll
            for (int kb = 0; kb < 8; ++kb) S[kb] = __builtin_amdgcn_mfma_f32_16x16x32_bf16(KEf[kb], ITf, S[kb] * DEC[kb], 0, 0, 0);
            f32x4 o0 = {0.f, 0.f, 0.f, 0.f}, o1 = o0;
            o0 = __builtin_amdgcn_mfma_f32_16x16x32_bf16(ITf, Af[0], o0, 0, 0, 0);
            o1 = __builtin_amdgcn_mfma_f32_16x16x32_bf16(ITf, Af[1], o1, 0, 0, 0);
#pragma unroll
            for (int kk = 0; kk < 4; ++kk) { o0 = __builtin_amdgcn_mfma_f32_16x16x32_bf16(Sb[kk], QDf[0][kk], o0, 0, 0, 0); o1 = __builtin_amdgcn_mfma_f32_16x16x32_bf16(Sb[kk], QDf[1][kk], o1, 0, 0, 0); }
            u32x2 w; w.x = cvt_pk_bf16(o0[0], o0[1]); w.y = cvt_pk_bf16(o0[2], o0[3]);
            *(u32x2*)(mo + (size_t)c * 32 * D) = w;
            w.x = cvt_pk_bf16(o1[0], o1[1]); w.y = cvt_pk_bf16(o1[2], o1[3]);
            *(u32x2*)(mo + (size_t)c * 32 * D + (size_t)16 * D) = w;
        }
        if (c == 0) CH_WAIT(2); else if (c == 1) CH_WAIT(4); else CH_WAIT(6);
        CH_RAWBAR();
    }
    if (comp) {
#pragma unroll
        for (int kb = 0; kb < 8; ++kb)
#pragma unroll
            for (int i = 0; i < 4; ++i) sout[(size_t)(16 * kb + 4 * g + i) * 128 + v0 + c16] = S[kb][i];
    }
    asm volatile("s_waitcnt vmcnt(0)" ::: "memory");
    CH_RAWBAR();
}
__device__ __forceinline__ void rec_norm_pass(const bf16_t* Z, const float* gain, bf16_t* MIX, int gw, int NGW, int lane) {
    const int part = lane & 15;
    const f32x4 g0 = *(const f32x4*)(gain + 8 * part), g1 = *(const f32x4*)(gain + 8 * part + 4);
    const int p0 = gw * 4 + (lane >> 4), NP = M * 8, step = NGW * 4;
    u32x4 ov, gv;
    { const int m = p0 >> 3, h = p0 & 7; ov = *(const u32x4*)(MIX + (size_t)m * D + 1024 + h * 128 + 8 * part); gv = __builtin_nontemporal_load((const u32x4*)(Z + (size_t)m * DIN + ZHG + h * 128 + 8 * part)); }
    for (int p = p0; p < NP; p += step) {
        const int m = p >> 3, h = p & 7, pn = p + step < NP ? p + step : p, mn = pn >> 3, hn = pn & 7;
        bf16_t* op = MIX + (size_t)m * D + 1024 + h * 128 + 8 * part;
        const u32x4 ovn = *(const u32x4*)(MIX + (size_t)mn * D + 1024 + hn * 128 + 8 * part), gvn = __builtin_nontemporal_load((const u32x4*)(Z + (size_t)mn * DIN + ZHG + hn * 128 + 8 * part));
        float x[8] = {bf_lo(ov.x), bf_hi(ov.x), bf_lo(ov.y), bf_hi(ov.y), bf_lo(ov.z), bf_hi(ov.z), bf_lo(ov.w), bf_hi(ov.w)};
        float s = 0.f;
#pragma unroll
        for (int j = 0; j < 8; ++j) s += x[j] * x[j];
        s += __shfl_xor(s, 1); s += __shfl_xor(s, 2); s += __shfl_xor(s, 4); s += __shfl_xor(s, 8);
        const float rs = rsqrtf(s * (1.f / 128.f) + EPS);
        u32x4 w;
        w.x = cvt_pk_bf16(x[0] * rs * g0.x * siluf_(bf_lo(gv.x)), x[1] * rs * g0.y * siluf_(bf_hi(gv.x)));
        w.y = cvt_pk_bf16(x[2] * rs * g0.z * siluf_(bf_lo(gv.y)), x[3] * rs * g0.w * siluf_(bf_hi(gv.y)));
        w.z = cvt_pk_bf16(x[4] * rs * g1.x * siluf_(bf_lo(gv.z)), x[5] * rs * g1.y * siluf_(bf_hi(gv.z)));
        w.w = cvt_pk_bf16(x[6] * rs * g1.z * siluf_(bf_lo(gv.w)), x[7] * rs * g1.w * siluf_(bf_hi(gv.w)));
        *(u32x4*)op = w;
        ov = ovn; gv = gvn;
    }
}
constexpr int KS_STRIDE = 136, VT_STRIDE = 196;
constexpr int ATT_KS = 0, ATT_VT = 192 * KS_STRIDE * 2, ATT_BT = ATT_VT + 128 * VT_STRIDE * 2, ATT_END = ATT_BT + 4 * 256 * 4;
static_assert(ATT_END <= 131072, "attention LDS");
__device__ __forceinline__ void attn_item(const bf16_t* Z, const float* ck, const float* cv, const float* btab, const float* sinks, bf16_t* MIX, int item, LAS unsigned char* lds, int tid, int wave, int lane) {
    asm volatile("" : "+v"(tid), "+v"(lane)); __builtin_assume(lane >= 0 && lane < 64 && tid >= 0 && tid < 512);
    LAS bf16_t* Ks = (LAS bf16_t*)(lds + ATT_KS); LAS bf16_t* VTs = (LAS bf16_t*)(lds + ATT_VT); LAS float* bts = (LAS float*)(lds + ATT_BT);
    const bool prompt = item < 1024;
    int kvh, qrow0, krow0, kmin, sidx = 0;
    if (prompt) { const int b = item >> 8, c = (item >> 1) & 127; kvh = item & 1; qrow0 = b * 8192 + c * 64; krow0 = qrow0 - 128; kmin = c == 0 ? 128 : (c == 1 ? 64 : 0); }
    else { sidx = (item - 1024) >> 1; kvh = item & 1; qrow0 = MP + sidx * 64; krow0 = qrow0 - 128; kmin = 0; }
#pragma unroll 2
    for (int it = 0; it < 6; ++it) {
        const int task = tid + NTHR * it, kq = task & 3, key = (task >> 2) % 192, ch = (task / 768) * 4 + kq;
        u32x4 kv4 = {0u, 0u, 0u, 0u}, vv4 = {0u, 0u, 0u, 0u};
        if (!prompt && key < 128) {
            const float* kp = ck + ((size_t)(sidx * 128 + key) * 2 + kvh) * 128 + ch * 8; const float* vp = cv + ((size_t)(sidx * 128 + key) * 2 + kvh) * 128 + ch * 8;
            const f32x4 a = *(const f32x4*)kp, b = *(const f32x4*)(kp + 4), c = *(const f32x4*)vp, d = *(const f32x4*)(vp + 4);
            kv4 = (u32x4){cvt_pk_bf16(a.x, a.y), cvt_pk_bf16(a.z, a.w), cvt_pk_bf16(b.x, b.y), cvt_pk_bf16(b.z, b.w)};
            vv4 = (u32x4){cvt_pk_bf16(c.x, c.y), cvt_pk_bf16(c.z, c.w), cvt_pk_bf16(d.x, d.y), cvt_pk_bf16(d.z, d.w)};
        } else if (key >= kmin) {
            const bf16_t* zp = Z + (size_t)(krow0 + key) * DIN + ZK + kvh * 128 + ch * 8;
            kv4 = *(const u32x4*)zp; vv4 = *(const u32x4*)(zp + 256);
        }
        *(LAS u32x4*)(Ks + key * KS_STRIDE + ch * 8) = kv4;
        LAS bf16_t* vt = VTs + (ch * 8) * VT_STRIDE + key;
        vt[0 * VT_STRIDE] = (bf16_t)(vv4.x & 0xffffu); vt[1 * VT_STRIDE] = (bf16_t)(vv4.x >> 16); vt[2 * VT_STRIDE] = (bf16_t)(vv4.y & 0xffffu); vt[3 * VT_STRIDE] = (bf16_t)(vv4.y >> 16);
        vt[4 * VT_STRIDE] = (bf16_t)(vv4.z & 0xffffu); vt[5 * VT_STRIDE] = (bf16_t)(vv4.z >> 16); vt[6 * VT_STRIDE] = (bf16_t)(vv4.w & 0xffffu); vt[7 * VT_STRIDE] = (bf16_t)(vv4.w >> 16);
    }
    for (int i = tid; i < 1024; i += NTHR) bts[i] = btab[(kvh * 4 + (i >> 8)) * 256 + (i & 255)];
    const int c16 = lane & 15, g = lane >> 4, gh = wave >> 1, qhalf = wave & 1, hq = kvh * 4 + gh;
    bf16x8 Qf[2][4];
#pragma unroll
    for (int nb = 0; nb < 2; ++nb)
#pragma unroll
        for (int kk = 0; kk < 4; ++kk) Qf[nb][kk] = *(const bf16x8*)(Z + (size_t)(qrow0 + qhalf * 32 + nb * 16 + c16) * DIN + ZQ + hq * 128 + 32 * kk + 8 * g);
    const float sink = sinks[hq];
    __syncthreads();
    f32x4 sacc[12][2];
#pragma unroll
    for (int mb = 0; mb < 12; ++mb) { sacc[mb][0] = (f32x4){0.f, 0.f, 0.f, 0.f}; sacc[mb][1] = (f32x4){0.f, 0.f, 0.f, 0.f};
#pragma unroll
        for (int kk = 0; kk < 4; ++kk) { const bf16x8 Kf = *(const LAS bf16x8*)(Ks + (16 * mb + c16) * KS_STRIDE + 32 * kk + 8 * g);
            sacc[mb][0] = __builtin_amdgcn_mfma_f32_16x16x32_bf16(Kf, Qf[0][kk], sacc[mb][0], 0, 0, 0);
            sacc[mb][1] = __builtin_amdgcn_mfma_f32_16x16x32_bf16(Kf, Qf[1][kk], sacc[mb][1], 0, 0, 0); } }
    float inv[2];
    const float scale = 0.08838834764831845f;
#pragma unroll
    for (int nb = 0; nb < 2; ++nb) {
        const int qidx = qhalf * 32 + nb * 16 + c16; float mx = -3.0e38f;
#pragma unroll
        for (int mb = 0; mb < 12; ++mb)
#pragma unroll
            for (int i = 0; i < 4; ++i) { const int kidx = 16 * mb + 4 * g + i; float s = sacc[mb][nb][i] * scale + bts[gh * 256 + kidx - qidx + 63]; s = kidx < kmin ? -1e30f : s; sacc[mb][nb][i] = s; mx = fmaxf(mx, s); }
        mx = fmaxf(mx, __shfl_xor(mx, 16)); mx = fmaxf(mx, __shfl_xor(mx, 32)); mx = fmaxf(mx, sink);
        float sum = 0.f;
#pragma unroll
        for (int mb = 0; mb < 12; ++mb)
#pragma unroll
            for (int i = 0; i < 4; ++i) { const float e = __expf(sacc[mb][nb][i] - mx); sum += e; sacc[mb][nb][i] = e; }
        sum += __shfl_xor(sum, 16); sum += __shfl_xor(sum, 32); sum += __expf(sink - mx);
        inv[nb] = 1.0f / sum;
    }
    bf16x8 Pf[2][6];
#pragma unroll
    for (int nb = 0; nb < 2; ++nb)
#pragma unroll
        for (int ks = 0; ks < 6; ++ks) { u32x4 p; p.x = cvt_pk_bf16(sacc[2 * ks][nb][0], sacc[2 * ks][nb][1]); p.y = cvt_pk_bf16(sacc[2 * ks][nb][2], sacc[2 * ks][nb][3]);
            p.z = cvt_pk_bf16(sacc[2 * ks + 1][nb][0], sacc[2 * ks + 1][nb][1]); p.w = cvt_pk_bf16(sacc[2 * ks + 1][nb][2], sacc[2 * ks + 1][nb][3]); Pf[nb][ks] = __builtin_bit_cast(bf16x8, p); }
#pragma unroll
    for (int db = 0; db < 8; ++db) {
        f32x4 o0 = {0.f, 0.f, 0.f, 0.f}, o1 = {0.f, 0.f, 0.f, 0.f};
#pragma unroll
        for (int ks = 0; ks < 6; ++ks) { const LAS bf16_t* vp = VTs + (16 * db + c16) * VT_STRIDE + 32 * ks + 4 * g; const u32x2 lo = *(const LAS u32x2*)vp, hi = *(const LAS u32x2*)(vp + 16);
            const bf16x8 Vf = __builtin_bit_cast(bf16x8, ((u32x4){lo.x, lo.y, hi.x, hi.y}));
            o0 = __builtin_amdgcn_mfma_f32_16x16x32_bf16(Vf, Pf[0][ks], o0, 0, 0, 0);
            o1 = __builtin_amdgcn_mfma_f32_16x16x32_bf16(Vf, Pf[1][ks], o1, 0, 0, 0); }
        o0 = o0 * inv[0]; o1 = o1 * inv[1];
        u32x2 w0, w1; w0.x = cvt_pk_bf16(o0[0], o0[1]); w0.y = cvt_pk_bf16(o0[2], o0[3]); w1.x = cvt_pk_bf16(o1[0], o1[1]); w1.y = cvt_pk_bf16(o1[2], o1[3]);
        *(u32x2*)(MIX + (size_t)(qrow0 + qhalf * 32 + c16) * D + hq * 128 + 16 * db + 4 * g) = w0;
        *(u32x2*)(MIX + (size_t)(qrow0 + qhalf * 32 + 16 + c16) * D + hq * 128 + 16 * db + 4 * g) = w1;
    }
    __syncthreads();
}
#define XB_TMO      128
#define XB_XCNT(j)  (256  + 64 * (j))
#define XB_XSUB(j)  (1280 + 64 * (j))
#define XB_XGEN(j)  (2304 + 64 * (j))
#define XB_TOP      3328
#define XB_TOPGEN   3392
#define XCD_BAR_WORDS 3456
#define XB_SPIN_CAP (1u << 18)

__device__ __forceinline__ unsigned xb_ld(unsigned* p)              { return __hip_atomic_load(p, __ATOMIC_RELAXED, __HIP_MEMORY_SCOPE_AGENT); }
__device__ __forceinline__ unsigned xb_add(unsigned* p, unsigned v) { return __hip_atomic_fetch_add(p, v, __ATOMIC_RELAXED, __HIP_MEMORY_SCOPE_AGENT); }
__device__ __forceinline__ unsigned xb_xcc_id() { return (unsigned)__builtin_amdgcn_s_getreg((3 << 11) | 20) & 0xFu; }
#define XB_SPIN(cond, bar) do { unsigned _sp = 0; while (cond) { __builtin_amdgcn_s_sleep(1); \
    if ((++_sp & 255u) == 0u) { if (xb_ld(&(bar)[XB_TMO])) break; if (_sp > XB_SPIN_CAP) { atomicAdd(&(bar)[XB_TMO], 1u); break; } } } } while (0)

struct XcdBarrier {
    unsigned* bar; unsigned x;
    volatile LAS unsigned* st;
};

__device__ __forceinline__ XcdBarrier xcd_barrier_post(unsigned* bar, volatile LAS unsigned* st) {
    XcdBarrier b; b.bar = bar; b.x = xb_xcc_id(); b.st = st;
    if (threadIdx.x == 0) (void)xb_add(&bar[XB_XCNT(b.x)], 1u);
    return b;
}
__device__ __forceinline__ void xcd_barrier_complete(unsigned* bar, unsigned x, unsigned& nloc, unsigned& nx) {
    const unsigned G = gridDim.x * gridDim.y * gridDim.z;
    unsigned sum, cnt, mine, sp = 0u;
    for (;;) {
        sum = 0u; cnt = 0u; mine = 0u;
#pragma unroll
        for (unsigned j = 0; j < 16; ++j) { const unsigned c = xb_ld(&bar[XB_XCNT(j)]); sum += c; cnt += (c > 0u) ? 1u : 0u; mine = (j == x) ? c : mine; }
        if (sum == G) break;
        __builtin_amdgcn_s_sleep(1);
        if ((++sp & 255u) == 0u) { if (xb_ld(&bar[XB_TMO])) break; if (sp > XB_SPIN_CAP) { atomicAdd(&bar[XB_TMO], 1u); break; } }
    }
    nloc = mine > 0u ? mine : 1u; nx = cnt > 0u ? cnt : 1u;
}

__device__ __forceinline__ void xcd_barrier(const XcdBarrier& b) {
    asm volatile("s_waitcnt vmcnt(0)" ::: "memory");
    __syncthreads();
    if (threadIdx.x == 0) {
        unsigned* bar = b.bar;
        __builtin_amdgcn_s_waitcnt(0);
        unsigned nloc = b.st[0], nx = b.st[1];
        if (nloc == 0u) { xcd_barrier_complete(bar, b.x, nloc, nx); b.st[0] = nloc; b.st[1] = nx; }
        const unsigned old = xb_add(&bar[XB_XSUB(b.x)], 1u);
        const unsigned gen = old / nloc;
        if (old + 1u == (gen + 1u) * nloc) {
            __builtin_amdgcn_fence(__ATOMIC_RELEASE, "agent");
            asm volatile("s_waitcnt vmcnt(0)" ::: "memory");
            const unsigned og = xb_add(&bar[XB_TOP], 1u);
            const unsigned tg = og / nx;
            if (og + 1u == (tg + 1u) * nx) xb_add(&bar[XB_TOPGEN], 1u);
            else XB_SPIN(xb_ld(&bar[XB_TOPGEN]) == tg, bar);
            __builtin_amdgcn_fence(__ATOMIC_ACQUIRE, "agent");
            xb_add(&bar[XB_XGEN(b.x)], 1u);
            asm volatile("s_waitcnt vmcnt(0)" ::: "memory");
        } else {
            XB_SPIN(xb_ld(&bar[XB_XGEN(b.x)]) == gen, bar);
            __builtin_amdgcn_fence(__ATOMIC_ACQUIRE, "agent");
            asm volatile("s_waitcnt vmcnt(0)" ::: "memory");
        }
    }
    __syncthreads();
}

constexpr int NPHASE = 16;
__global__ void __launch_bounds__(NTHR, 2) hybrid_fwd(Args args) {
    extern __shared__ __attribute__((aligned(16))) unsigned char lds_raw[];
    LAS unsigned char* lds = (LAS unsigned char*)lds_raw;
    cg::grid_group grid = cg::this_grid();
    const int tid = threadIdx.x, lane = tid & 63, wave = __builtin_amdgcn_readfirstlane(tid >> 6);
    const int G = gridDim.x, bx = blockIdx.x;
    const int gw = bx * NWAVES + wave, NGW = G * NWAVES;
    unsigned char* ws = args.ws; float* out = args.out;
    unsigned* ctl = (unsigned*)(ws + WS_CTL);
    bf16_t* W1GU = (bf16_t*)(ws + WS_W1GU); bf16_t* W1D = (bf16_t*)(ws + WS_W1D); bf16_t* WIN = (bf16_t*)(ws + WS_WIN); bf16_t* WOUT = (bf16_t*)(ws + WS_WOUT);
    bf16_t* W2GU = (bf16_t*)(ws + WS_W2GU); bf16_t* W2D = (bf16_t*)(ws + WS_W2D); bf16_t* WPG = (bf16_t*)(ws + WS_WPG); bf16_t* WPP = (bf16_t*)(ws + WS_WPP);
    float* BTAB = (float*)(ws + WS_BTAB);
    bf16_t* XN = (bf16_t*)(ws + WS_XN); bf16_t* MIX = XN; bf16_t* H = (bf16_t*)(ws + WS_H); bf16_t* Zb = H; bf16_t* U = (bf16_t*)(ws + WS_U); bf16_t* Y = (bf16_t*)(ws + WS_Y);
    bf16_t* XB0 = (bf16_t*)out; bf16_t* XB1 = (bf16_t*)(ws + WS_H);
    float* PART = (float*)(ws + WS_PART); unsigned char* REC = ws + WS_Y; bf16_t* PB = (bf16_t*)(ws + WS_PB);
    const int lo = args.lo, hi = args.hi;
#define IN(k) (lo <= (k) && (k) < hi)
#define SEAM(k) do { if (IN(k) && IN((k) + 1)) { if ((k) == 0) grid.sync(); else xcd_barrier(xbar); } } while (0)
    {   volatile LAS unsigned* bst = (volatile LAS unsigned*)(lds + 147408);
        if (tid < 2) bst[tid] = 0u;
        __syncthreads(); }
    const XcdBarrier xbar = xcd_barrier_post(ctl + CW_BAR, (volatile LAS unsigned*)(lds + 147408));

    if (IN(0)) {
        LAS float* scr = (LAS float*)(lds + wave * 16384);
        constexpr int IT_BIG = 32 * 176;
        constexpr int NITEMS = 2 * IT_BIG;
        for (int it = gw; it < NITEMS; it += NGW) {
            int r = it;
            if (transpose_mat(r, args.in[I_F1G], D, FF, W1GU, 1, scr, lane)) continue;
            transpose_mat(r, args.in[I_F1U], D, FF, W1GU, 2, scr, lane);
        }
        f32x4 xv[8];
        { const f32x4* xr = (const f32x4*)(args.in[I_XP] + (size_t)gw * D) + lane;
#pragma unroll
          for (int j = 0; j < 8; ++j) xv[j] = __builtin_nontemporal_load(&xr[64 * j]); }
        for (int m = gw; m < M; m += NGW) {
            const int mn = m + NGW < M ? m + NGW : m;
            const float* xrow = (mn < MP) ? args.in[I_XP] + (size_t)mn * D : args.in[I_XS] + (size_t)(mn - MP) * D;
            f32x4 xn[8];
#pragma unroll
            for (int j = 0; j < 8; ++j) xn[j] = __builtin_nontemporal_load(&((const f32x4*)xrow + lane)[64 * j]);
            rms_row_to_bf16(xv, args.in[I_F1PRE], XN + (size_t)m * D, lane);
#pragma unroll
            for (int j = 0; j < 8; ++j) xv[j] = xn[j];
            const float* prow = (m < MP) ? args.in[I_PP] + (size_t)m * PLE : args.in[I_PS] + (size_t)(m - MP) * PLE;
            const f32x4 pv = __builtin_nontemporal_load(&((const f32x4*)prow)[lane]); u32x2 w; w.x = cvt_pk_bf16(pv.x, pv.y); w.y = cvt_pk_bf16(pv.z, pv.w);
            ((u32x2*)(PB + (size_t)m * PLE))[lane] = w;
        }
        if (bx == 0) {
            for (int i = tid; i < 8 * 256; i += NTHR) {
                const int h = i >> 8, idx = i & 255, rel = idx - 191, n = rel < 0 ? -rel : rel;
                const int large = 8 + (n >= 12) + (n >= 16) + (n >= 23) + (n >= 32) + (n >= 46) + (n >= 64) + (n >= 91);
                const int bucket = (rel > 0 ? 16 : 0) + (n < 8 ? n : large);
                BTAB[i] = args.in[I_TAB][bucket * 8 + h];
            }
        }
    }
    SEAM(0);
    if (IN(1)) { { pg8::Gemm g{XN, W1GU, M, 2 * FF, D}; pg8::StaticOrder S; S.wgm = 16; S.init(M, 2 * FF, G, bx); pg8::EpiSwiGLU E{H, FF};
        pg8::gemm_phase<pg8::EpiSwiGLU, pg8::StaticOrder, true, true>(lds, g, S, E); }
        if (bx >= 96) { LAS float* scr = (LAS float*)(lds + wave * 16384); constexpr int IT_BIG = 32 * 176;
            for (int it = (bx - 96) * NWAVES + wave; it < 2 * IT_BIG; it += 160 * NWAVES) { int r = it;
                if (transpose_mat(r, args.in[I_F1D], FF, D, W1D, 0, scr, lane)) continue;
                transpose_mat(r, args.in[I_WIN], D, DIN, WIN, 0, scr, lane); } } }
    SEAM(1);
    if (IN(2)) {
        { pg8::Gemm g{H, W1D, M, D, FF}; pg8::RangeOrder<0, 4> S; S.init(M, D, G, bx); pg8::EpiBf16 E{Y, D};
          pg8::gemm_phase<pg8::EpiBf16, pg8::RangeOrder<0, 4>, true, true>(lds, g, S, E); }
        if (bx < 128) { const int hk = (bx & 1) * (FF / 2);
            pg8::Gemm g{H + hk, W1D + hk, M, D, FF / 2, FF}; pg8::RangeOrder<4, 5> S; S.init(M, D, G, bx >> 1); pg8::EpiF32Tile E{PART + (size_t)bx * 65536};
            pg8::gemm_phase<pg8::EpiF32Tile, pg8::RangeOrder<4, 5>, true, true>(lds, g, S, E); }
        else { LAS float* scr = (LAS float*)(lds + wave * 16384); constexpr int IT_BIG = 32 * 176;
            for (int it = (bx - 128) * NWAVES + wave; it < 2 * IT_BIG; it += 128 * NWAVES) { int r = it;
                if (transpose_mat(r, args.in[I_F2G], D, FF, W2GU, 1, scr, lane)) continue;
                transpose_mat(r, args.in[I_F2U], D, FF, W2GU, 2, scr, lane); } } }
    SEAM(2);
    if (IN(3)) norm_pass<false, true>(args.in[I_XP], args.in[I_XS], nullptr, Y, args.in[I_F1POST], 0.5f, args.in[I_MPRE], nullptr, XB0, XN, gw, NGW, lane, PART);
    SEAM(3);
    if (IN(4)) { { pg8::Gemm g{XN, WIN, M, DIN, D}; pg8::StaticOrder S; S.wgm = 16; S.init(M, DIN, G, bx); pg8::EpiBf16 E{Zb, DIN, true};
        pg8::gemm_phase<pg8::EpiBf16, pg8::StaticOrder, true, true>(lds, g, S, E); }
        if (bx >= 176) { LAS float* scr = (LAS float*)(lds + wave * 16384); constexpr int IT_SQ = 32 * 64, IT_PP = 4 * 64;
            for (int it = (bx - 176) * NWAVES + wave; it < IT_SQ + IT_PP; it += 80 * NWAVES) { int r = it;
                if (transpose_mat(r, args.in[I_WOUT], D, D, WOUT, 0, scr, lane)) continue;
                transpose_mat(r, args.in[I_WPP], PLE, D, WPP, 0, scr, lane); } } }
    SEAM(4);
    if (IN(5)) {
        for (int cidx = bx; cidx < M / 32; cidx += G) hgrn_prep_item(Zb, args.in[I_LB], REC, cidx, wave, lds + wave * PREP_WSTRIDE, lane);
        const int gt = bx * NTHR + tid, NGT = G * NTHR;
        for (int idx = gt; idx < 2 * (131072 + 1048576); idx += NGT) {
            if (idx < 262144) { const int which = idx >> 17, r = idx & 131071, b = r >> 15, j = (r >> 8) & 127, c = r & 255;
                out[O_KP + idx] = __uint_as_float((unsigned)Zb[(size_t)(b * 8192 + 8064 + j) * DIN + ZK + which * 256 + c] << 16); }
            else { const int r2 = idx - 262144, which = r2 >> 20, r = r2 & 1048575, s = r >> 15, j = (r >> 8) & 127, c = r & 255;
                float v;
                if (j < 64) v = args.in[which ? I_CV : I_CK][(size_t)(s * 128 + 64 + j) * 256 + c];
                else v = __uint_as_float((unsigned)Zb[(size_t)(MP + s * 64 + j - 64) * DIN + ZK + which * 256 + c] << 16);
                out[O_KS + r2] = v; }
        }
    }
    SEAM(5);
    if (IN(6)) {
        LAS int* qslot = (LAS int*)(lds + 147392);
        constexpr int N_PCH = 64, N_ATT = 1088, N_SCH = 512, N_ALL = N_PCH + N_ATT + N_SCH;
        for (;;) {
            if (tid == 0) *qslot = (int)atomicAdd(ctl + CW_QUEUE, 1u);
            __syncthreads();
            const int it = *qslot;
            __syncthreads();
            if (it >= N_ALL) break;
            if (it < N_PCH) { const int ch = it >> 1, b = ch >> 3, h = ch & 7;
                hgrn_chain(REC, nullptr, out + O_SP + (size_t)ch * 16384, MIX, b * 256, 256, h, it & 1, lds, wave, lane); }
            else if (it < N_PCH + N_ATT) attn_item(Zb, args.in[I_CK], args.in[I_CV], BTAB, args.in[I_SINK], MIX, it - N_PCH, lds, tid, wave, lane);
            else { const int si = it - N_PCH - N_ATT, sc = si >> 1, s = sc >> 3, h = sc & 7;
                hgrn_chain(REC, args.in[I_ST] + (size_t)sc * 16384, out + O_SS + (size_t)sc * 16384, MIX, 1024 + s * 2, 2, h, si & 1, lds, wave, lane); }
        }
    }
    SEAM(6);
    if (IN(7)) rec_norm_pass(Zb, args.in[I_HN], MIX, gw, NGW, lane);
    SEAM(7);
    if (IN(8)) { { pg8::Gemm g{MIX, WOUT, M, D, D}; pg8::StaticOrder S; S.init(M, D, G, bx); pg8::EpiBf16 E{Y, D};
        pg8::gemm_phase<pg8::EpiBf16, pg8::StaticOrder, true, true>(lds, g, S, E); }
        if (G == 256 ? bx >= 64 : true) { pg8::Gemm g{PB, WPP, M, D, PLE}; pg8::StaticOrder S; if (G == 256) S.init(M, D, 192, bx - 64); else S.init(M, D, G, bx); pg8::EpiBf16 E{U, D};
            pg8::gemm_phase<pg8::EpiBf16, pg8::StaticOrder, true, true>(lds, g, S, E); } }
    SEAM(8);
    if (IN(9)) norm_pass<true, true>(nullptr, nullptr, XB0, Y, args.in[I_MPOST], 1.0f, args.in[I_F2PRE], nullptr, XB0, XN, gw, NGW, lane);
    SEAM(9);
    if (IN(10)) { { pg8::Gemm g{XN, W2GU, M, 2 * FF, D}; pg8::StaticOrder S; S.wgm = 16; S.init(M, 2 * FF, G, bx); pg8::EpiSwiGLU E{H, FF};
        pg8::gemm_phase<pg8::EpiSwiGLU, pg8::StaticOrder, true, true>(lds, g, S, E); }
        if (bx >= 96) { LAS float* scr = (LAS float*)(lds + wave * 16384); constexpr int IT_BIG = 32 * 176, IT_SQ = 32 * 64;
            for (int it = (bx - 96) * NWAVES + wave; it < IT_BIG + IT_SQ; it += 160 * NWAVES) { int r = it;
                if (transpose_mat(r, args.in[I_F2D], FF, D, W2D, 0, scr, lane)) continue;
                transpose_mat(r, args.in[I_WPG], D, D, WPG, 0, scr, lane); } } }
    SEAM(10);
    if (IN(11)) {
        { pg8::Gemm g{H, W2D, M, D, FF}; pg8::RangeOrder<0, 4> S; S.init(M, D, G, bx); pg8::EpiBf16 E{Y, D};
          pg8::gemm_phase<pg8::EpiBf16, pg8::RangeOrder<0, 4>, true, true>(lds, g, S, E); }
        if (bx < 128) { const int hk = (bx & 1) * (FF / 2);
            pg8::Gemm g{H + hk, W2D + hk, M, D, FF / 2, FF}; pg8::RangeOrder<4, 5> S; S.init(M, D, G, bx >> 1); pg8::EpiF32Tile E{PART + (size_t)bx * 65536};
            pg8::gemm_phase<pg8::EpiF32Tile, pg8::RangeOrder<4, 5>, true, true>(lds, g, S, E); } }
    SEAM(11);
    if (IN(12)) norm_pass<true, true>(nullptr, nullptr, XB0, Y, args.in[I_F2POST], 0.5f, args.in[I_PPRE], nullptr, XB1, XN, gw, NGW, lane, PART);
    SEAM(12);
    if (IN(14)) { pg8::Gemm g{XN, WPG, M, D, D}; pg8::StaticOrder S; S.init(M, D, G, bx); pg8::EpiSigMul E{Y, U, D};
        pg8::gemm_phase<pg8::EpiSigMul, pg8::StaticOrder, true, true>(lds, g, S, E); }
    SEAM(14);
    if (IN(15)) norm_pass<true, false>(nullptr, nullptr, XB1, Y, args.in[I_PPOST], 1.0f, nullptr, out, nullptr, nullptr, gw, NGW, lane);
#undef IN
#undef SEAM
}

extern "C" void kernel_launch(void* const* d_in, const int* in_sizes, int n_in, void* d_out, int out_size, void* d_ws, size_t ws_size, hipStream_t stream) {
    static int grid = 0;
    if (grid == 0) {
        if (n_in != 29 || (size_t)out_size != O_END || ws_size < WS_END) { fprintf(stderr, "kernel_launch: unexpected sizes n_in %d out %d ws %zu\n", n_in, out_size, ws_size); grid = -1; return; }
        int dev = 0, cus = 0, per_cu = 0;
        hipGetDevice(&dev); hipDeviceGetAttribute(&cus, hipDeviceAttributeMultiprocessorCount, dev);
        if (hipFuncSetAttribute((const void*)hybrid_fwd, hipFuncAttributeMaxDynamicSharedMemorySize, LDS_BYTES) != hipSuccess) { fprintf(stderr, "kernel_launch: hipFuncSetAttribute failed\n"); grid = -1; return; }
        if (hipOccupancyMaxActiveBlocksPerMultiprocessor(&per_cu, (const void*)hybrid_fwd, NTHR, LDS_BYTES) != hipSuccess || per_cu < 1) per_cu = 1;
        (void)hipGetLastError();
        grid = cus * per_cu;
        if (grid != 256) { fprintf(stderr, "kernel_launch: this build needs a 256-workgroup grid (got %d)\n", grid); grid = -1; return; }
        fprintf(stderr, "kernel_launch: grid %d (cus %d x %d)\n", grid, cus, per_cu);
    }
    if (grid < 0) return;
    hipMemsetAsync((char*)d_ws + WS_CTL, 0, CTL_BYTES, stream);
    Args a{};
    for (int i = 0; i < 29; ++i) a.in[i] = (const float*)d_in[i];
    a.out = (float*)d_out; a.ws = (unsigned char*)d_ws; a.lo = 0; a.hi = NPHASE;
    void* kargs[] = {&a};
    hipError_t e = hipLaunchCooperativeKernel((const void*)hybrid_fwd, dim3(grid), dim3(NTHR), kargs, LDS_BYTES, stream);
    if (e != hipSuccess) fprintf(stderr, "kernel_launch: cooperative launch failed: %s (grid %d)\n", hipGetErrorString(e), grid);
}
```

```cpp
#include <hip/hip_runtime.h>
#include <hip/hip_cooperative_groups.h>
#include <cstdio>
#include <cstdint>
namespace cg = cooperative_groups;
namespace pg8 {
#define PG8_LAS __attribute__((address_space(3)))
typedef unsigned short bf16_t;
typedef short bf16x8 __attribute__((ext_vector_type(8)));
typedef float f32x4 __attribute__((ext_vector_type(4)));
typedef unsigned u32x4 __attribute__((ext_vector_type(4)));
constexpr int BM = 256, BK = 64, HALF = 128, HTB = HALF * BK * 2  , STAGE_BYTES = 8 * HTB, NXCD = 8, WGM = 8;

__host__ __device__ __forceinline__ int lds_byte(int r, int c) { const int st = (r >> 4) * 2 + (c >> 5), rr = r & 15, cc = c & 31, ob = rr * 64 + cc * 2; return st * 1024 + (ob ^ (((ob >> 9) & 1) << 5)); }
__host__ __device__ __forceinline__ void stage_rc(int b, int& R, int& C) { const int st = b / 1024, sb = b % 1024, swz = sb ^ (((sb >> 9) & 1) << 5); R = (st >> 1) * 16 + swz / 64; C = (st & 1) * 32 + (swz % 64) / 2; }
__host__ __device__ __forceinline__ int perm32(int rho) { const int n = rho >> 4, i = rho & 15; return 8 * (i >> 2) + 4 * n + (i & 3); }

struct Unit { int pm, pn; };
struct Gemm { const bf16_t* A; const bf16_t* Bt; int M, N, K; int ld = 0; };

struct StaticOrder {
    int nM, nN, nwg, G, c;
    __host__ __device__ void init(int M, int N, int G_, int c_) { nM = M / BM; nN = N / BM; nwg = nM * nN; G = G_; c = c_; }
    __host__ __device__ bool next(int i, Unit& u) const {
        const long L = (long)i * G + c; if (L >= nwg) return false;
        int wgid = (int)L; { const int q = nwg / NXCD, r = nwg % NXCD, xcd = wgid % NXCD, off = wgid / NXCD; wgid = (xcd < r ? xcd * (q + 1) : r * (q + 1) + (xcd - r) * q) + off; }
        const int nig = WGM * nN, gid = wgid / nig, fm = gid * WGM, gsz = (nM - fm) < WGM ? (nM - fm) : WGM;
        u.pm = fm + ((wgid % nig) % gsz); u.pn = (wgid % nig) / gsz; return true;
    }
    __device__ __forceinline__ void a_ready(const Unit&) const {}
    __device__ __forceinline__ void done(const Unit&) const {}
};

template <int I0, int I1> struct RangeOrder : StaticOrder {
    __host__ __device__ bool next(int i, Unit& u) const { return (i + I0 < I1) && StaticOrder::next(i + I0, u); }
};
typedef __bf16 bf16x2_cv __attribute__((ext_vector_type(2)));
typedef float f32x2_cv __attribute__((ext_vector_type(2)));
__device__ __forceinline__ unsigned cvt_pk_bf16(float lo, float hi) { const f32x2_cv v = {lo, hi}; return __builtin_bit_cast(unsigned, __builtin_convertvector(v, bf16x2_cv)); }
__device__ __forceinline__ float bf_lo(unsigned u) { return __uint_as_float(u << 16); }
__device__ __forceinline__ float bf_hi(unsigned u) { return __uint_as_float(u & 0xffff0000u); }
__device__ __forceinline__ float sigmoidf_(float x) { return __builtin_amdgcn_rcpf(1.0f + __expf(-x)); }
__device__ __forceinline__ float siluf_(float x) { return x * sigmoidf_(x); }

struct EpiBf16 {
    static constexpr bool PERM = true, AFTER_DRAIN = false;
    bf16_t* O; int ldc; bool nt = false;
    __device__ __forceinline__ void operator()(const f32x4 (&acc)[2][2][4][2], const Unit& u, int wr, int wc, int fr, int fq) const {
        const int row0 = u.pm * BM + wr * 64 + fr, col0 = u.pn * BM + wc * 32 + 8 * fq;
#pragma unroll
        for (int ai = 0; ai < 2; ++ai)
#pragma unroll
            for (int m = 0; m < 4; ++m) { bf16_t* rowp = O + (size_t)(row0 + ai * HALF + m * 16) * ldc + col0;
#pragma unroll
                for (int bj = 0; bj < 2; ++bj) { const f32x4 v0 = acc[ai][bj][m][0], v1 = acc[ai][bj][m][1];
                    u32x4 w; w.x = cvt_pk_bf16(v0[0], v0[1]); w.y = cvt_pk_bf16(v0[2], v0[3]); w.z = cvt_pk_bf16(v1[0], v1[1]); w.w = cvt_pk_bf16(v1[2], v1[3]);
                    if (nt) __builtin_nontemporal_store(w, (u32x4*)(rowp + bj * HALF)); else *(u32x4*)(rowp + bj * HALF) = w; } }
    }
};
struct EpiF32Tile {
    static constexpr bool PERM = true, AFTER_DRAIN = false;
    float* P;
    __device__ __forceinline__ void operator()(const f32x4 (&acc)[2][2][4][2], const Unit&, int wr, int wc, int fr, int fq) const {
        const int row0 = wr * 64 + fr, col0 = wc * 32 + 8 * fq;
#pragma unroll
        for (int ai = 0; ai < 2; ++ai)
#pragma unroll
            for (int m = 0; m < 4; ++m) { float* rowp = P + (size_t)(row0 + ai * HALF + m * 16) * 256 + col0;
#pragma unroll
                for (int bj = 0; bj < 2; ++bj) { *(f32x4*)(rowp + bj * HALF) = acc[ai][bj][m][0]; *(f32x4*)(rowp + bj * HALF + 4) = acc[ai][bj][m][1]; } }
    }
};
struct EpiSwiGLU {
    static constexpr bool PERM = true, AFTER_DRAIN = false;
    bf16_t* O; int ldc;
    __device__ __forceinline__ void operator()(const f32x4 (&acc)[2][2][4][2], const Unit& u, int wr, int wc, int fr, int fq) const {
        const int row0 = u.pm * BM + wr * 64 + fr, col0 = u.pn * HALF + wc * 32 + 8 * fq;
#pragma unroll
        for (int ai = 0; ai < 2; ++ai)
#pragma unroll
            for (int m = 0; m < 4; ++m) { bf16_t* rowp = O + (size_t)(row0 + ai * HALF + m * 16) * ldc + col0;
                const f32x4 g0 = acc[ai][0][m][0], g1 = acc[ai][0][m][1], u0 = acc[ai][1][m][0], u1 = acc[ai][1][m][1];
                u32x4 w; w.x = cvt_pk_bf16(siluf_(g0[0]) * u0[0], siluf_(g0[1]) * u0[1]); w.y = cvt_pk_bf16(siluf_(g0[2]) * u0[2], siluf_(g0[3]) * u0[3]);
                w.z = cvt_pk_bf16(siluf_(g1[0]) * u1[0], siluf_(g1[1]) * u1[1]); w.w = cvt_pk_bf16(siluf_(g1[2]) * u1[2], siluf_(g1[3]) * u1[3]);
                __builtin_nontemporal_store(w, (u32x4*)rowp); }
    }
};
struct EpiSigMul {
    static constexpr bool PERM = true, AFTER_DRAIN = false;
    bf16_t* O; const bf16_t* U; int ldc;
    __device__ __forceinline__ void operator()(const f32x4 (&acc)[2][2][4][2], const Unit& u, int wr, int wc, int fr, int fq) const {
        const int row0 = u.pm * BM + wr * 64 + fr, col0 = u.pn * BM + wc * 32 + 8 * fq;
#pragma unroll
        for (int ai = 0; ai < 2; ++ai)
#pragma unroll
            for (int m = 0; m < 4; ++m) { const size_t off = (size_t)(row0 + ai * HALF + m * 16) * ldc + col0;
#pragma unroll
                for (int bj = 0; bj < 2; ++bj) { const f32x4 v0 = acc[ai][bj][m][0], v1 = acc[ai][bj][m][1];
                    const u32x4 uu = *(const u32x4*)(U + off + bj * HALF);
                    u32x4 w; w.x = cvt_pk_bf16(sigmoidf_(v0[0]) * bf_lo(uu.x), sigmoidf_(v0[1]) * bf_hi(uu.x)); w.y = cvt_pk_bf16(sigmoidf_(v0[2]) * bf_lo(uu.y), sigmoidf_(v0[3]) * bf_hi(uu.y));
                    w.z = cvt_pk_bf16(sigmoidf_(v1[0]) * bf_lo(uu.z), sigmoidf_(v1[1]) * bf_hi(uu.z)); w.w = cvt_pk_bf16(sigmoidf_(v1[2]) * bf_lo(uu.w), sigmoidf_(v1[3]) * bf_hi(uu.w));
                    *(u32x4*)(O + off + bj * HALF) = w; } }
    }
};
template <class Epi, class Sched, bool ALIGN_EPI = false, bool SP2 = false>
__device__ __forceinline__ void gemm_phase(PG8_LAS unsigned char* lds, const Gemm g, const Sched& S, const Epi& E) {
    const int tid = threadIdx.x, wid = __builtin_amdgcn_readfirstlane(tid >> 6), lane = tid & 63, wr = wid >> 2, wc = wid & 3, fr = lane & 15, fq = lane >> 4;
    const int K = g.K, nt = K / BK, LD = g.ld ? g.ld : g.K;
    unsigned voffA[2], voffB[2];
#pragma unroll
    for (int i = 0; i < 2; ++i) { int R, C; stage_rc(tid * 16 + i * 8192, R, C); const int Rb = Epi::PERM ? ((R & ~31) + perm32(R & 31)) : R;
        voffA[i] = (unsigned)(R * LD + C) * 2u; voffB[i] = (unsigned)(Rb * LD + C) * 2u; }
    const size_t kstep = (size_t)(BK * 2);
    const size_t hstep = (size_t)HALF * LD * 2;
    const size_t tstep = 2 * hstep;
    const unsigned ldsw = (unsigned)wid * 1024u;
    const int aoff = lds_byte(wr * 64 + fr, fq * 8), boff = lds_byte(wc * 32 + fr, fq * 8);
#define PG8_SA(b, h) (((b) * 2 + (h)) * HTB)
#define PG8_SB(b, h) ((4 + (b) * 2 + (h)) * HTB)
#define PG8_STAGE(bufoff, gbase, voff) do { _Pragma("unroll") for (int _i = 0; _i < 2; ++_i) \
        __builtin_amdgcn_global_load_lds((const unsigned*)((const char*)(gbase) + (voff)[_i]), (PG8_LAS unsigned*)(lds + (bufoff) + ldsw + _i * 8192), 16, 0, 0); } while (0)
#define PG8_LDA(dst, b, h) do { _Pragma("unroll") for (int m = 0; m < 4; ++m) _Pragma("unroll") for (int k = 0; k < 2; ++k) dst[m][k] = *(const PG8_LAS bf16x8*)(lds + PG8_SA(b, h) + aoff + m * 2048 + k * 1024); } while (0)
#define PG8_LDB(dst, b, h) do { _Pragma("unroll") for (int n = 0; n < 2; ++n) _Pragma("unroll") for (int k = 0; k < 2; ++k) dst[n][k] = *(const PG8_LAS bf16x8*)(lds + PG8_SB(b, h) + boff + n * 2048 + k * 1024); } while (0)
#define PG8_MMA(ai, bj, At, Bt) do { __builtin_amdgcn_s_setprio(1); _Pragma("unroll") for (int m = 0; m < 4; ++m) _Pragma("unroll") for (int n = 0; n < 2; ++n) _Pragma("unroll") for (int k = 0; k < 2; ++k) \
        acc[ai][bj][m][n] = __builtin_amdgcn_mfma_f32_16x16x32_bf16(Bt[n][k], At[m][k], acc[ai][bj][m][n], 0, 0, 0); __builtin_amdgcn_s_setprio(0); } while (0)
#define PG8_WAIT_V(n) asm volatile("s_waitcnt vmcnt(" #n ")" ::: "memory")
#define PG8_WAIT_L(n) asm volatile("s_waitcnt lgkmcnt(" #n ")" ::: "memory")
#define PG8_BAR __builtin_amdgcn_s_barrier()
#define PG8_SCHED __builtin_amdgcn_sched_barrier(0)
    Unit cur, nxt; int ui = 0;
    if (!S.next(0, cur)) return;
    f32x4 acc[2][2][4][2];
#pragma unroll
    for (int a = 0; a < 2; ++a)
#pragma unroll
        for (int b = 0; b < 2; ++b)
#pragma unroll
            for (int m = 0; m < 4; ++m)
#pragma unroll
                for (int n = 0; n < 2; ++n) acc[a][b][m][n] = (f32x4){0.f, 0.f, 0.f, 0.f};
    bf16x8 At[4][2], B0[2][2], B1[2][2];
    const char* cA = (const char*)g.A + (size_t)cur.pm * tstep; const char* cB = (const char*)g.Bt + (size_t)cur.pn * tstep;
    S.a_ready(cur);
    if constexpr (SP2) {
        PG8_STAGE(PG8_SB(0, 0), cB, voffB); PG8_STAGE(PG8_SB(0, 1), cB + hstep, voffB); PG8_STAGE(PG8_SA(0, 0), cA, voffA); PG8_STAGE(PG8_SA(0, 1), cA + hstep, voffA);
        if (wr == 1) PG8_BAR;
        PG8_WAIT_V(2); PG8_BAR;
        PG8_STAGE(PG8_SB(1, 0), cB + kstep, voffB); PG8_STAGE(PG8_SA(1, 0), cA + kstep, voffA); PG8_STAGE(PG8_SB(1, 1), cB + hstep + kstep, voffB);
        PG8_WAIT_V(6); PG8_BAR;
    } else {
        PG8_STAGE(PG8_SB(0, 0), cB, voffB); PG8_STAGE(PG8_SA(0, 0), cA, voffA); PG8_STAGE(PG8_SB(0, 1), cB + hstep, voffB); PG8_STAGE(PG8_SA(0, 1), cA + hstep, voffA);
        if (wr == 1) PG8_BAR;
        PG8_WAIT_V(4); PG8_BAR;
        PG8_STAGE(PG8_SB(1, 0), cB + kstep, voffB); PG8_STAGE(PG8_SA(1, 0), cA + kstep, voffA); PG8_STAGE(PG8_SB(1, 1), cB + hstep + kstep, voffB);
        PG8_WAIT_V(6); PG8_BAR;
    }
    for (;;) {
        const bool has_next = S.next(ui + 1, nxt);
        const char* nA = has_next ? (const char*)g.A + (size_t)nxt.pm * tstep : cA; const char* nB = has_next ? (const char*)g.Bt + (size_t)nxt.pn * tstep : cB;
        for (int t = 0; t < nt; t += 2) {
            const bool last = (t == nt - 2);
            const char* a1 = cA + (size_t)(t + 1) * kstep;
            const char* a2 = last ? nA : cA + (size_t)(t + 2) * kstep; const char* b2 = last ? nB : cB + (size_t)(t + 2) * kstep;
            const char* a3 = a2 + kstep; const char* b3 = b2 + kstep;
            if (last && has_next) S.a_ready(nxt);
            if constexpr (SP2) {
            PG8_LDB(B0, 0, 0); PG8_LDB(B1, 0, 1); PG8_SCHED; PG8_LDA(At, 0, 0); PG8_STAGE(PG8_SA(1, 1), a1 + hstep, voffA);
            PG8_WAIT_V(8); PG8_WAIT_L(0); PG8_BAR; PG8_MMA(0, 0, At, B0); PG8_MMA(0, 1, At, B1); PG8_BAR; PG8_SCHED;
            PG8_LDA(At, 0, 1); PG8_STAGE(PG8_SB(0, 0), b2, voffB); PG8_STAGE(PG8_SB(0, 1), b2 + hstep, voffB); PG8_STAGE(PG8_SA(0, 0), a2, voffA);
            PG8_WAIT_V(8); PG8_WAIT_L(0); PG8_BAR; PG8_MMA(1, 0, At, B0); PG8_MMA(1, 1, At, B1); PG8_BAR; PG8_SCHED;
            PG8_LDB(B0, 1, 0); PG8_LDB(B1, 1, 1); PG8_SCHED; PG8_LDA(At, 1, 0); PG8_STAGE(PG8_SA(0, 1), a2 + hstep, voffA);
            PG8_WAIT_V(8); PG8_WAIT_L(0); PG8_BAR; PG8_MMA(0, 0, At, B0); PG8_MMA(0, 1, At, B1); PG8_BAR; PG8_SCHED;
            PG8_LDA(At, 1, 1); PG8_STAGE(PG8_SB(1, 0), b3, voffB); PG8_STAGE(PG8_SB(1, 1), b3 + hstep, voffB); PG8_STAGE(PG8_SA(1, 0), a3, voffA);
            PG8_WAIT_V(8); PG8_WAIT_L(0); PG8_BAR; PG8_MMA(1, 0, At, B0); PG8_MMA(1, 1, At, B1); PG8_BAR; PG8_SCHED;
            } else {
            PG8_LDB(B0, 0, 0); PG8_SCHED; PG8_LDA(At, 0, 0); PG8_STAGE(PG8_SA(1, 1), a1 + hstep, voffA);
            PG8_WAIT_L(8); PG8_BAR; PG8_WAIT_L(0); PG8_MMA(0, 0, At, B0); PG8_BAR; PG8_SCHED;
            PG8_LDB(B1, 0, 1); PG8_STAGE(PG8_SB(0, 0), b2, voffB);
            PG8_BAR; PG8_WAIT_L(0); PG8_MMA(0, 1, At, B1); PG8_BAR;
            PG8_LDA(At, 0, 1); PG8_STAGE(PG8_SA(0, 0), a2, voffA);
            PG8_BAR; PG8_WAIT_L(0); PG8_MMA(1, 0, At, B0); PG8_BAR; PG8_SCHED;
            PG8_STAGE(PG8_SB(0, 1), b2 + hstep, voffB);
            PG8_WAIT_V(6); PG8_BAR; PG8_MMA(1, 1, At, B1); PG8_BAR;
            PG8_LDB(B0, 1, 0); PG8_SCHED; PG8_LDA(At, 1, 0); PG8_STAGE(PG8_SA(0, 1), a2 + hstep, voffA);
            PG8_WAIT_L(8); PG8_BAR; PG8_WAIT_L(0); PG8_MMA(0, 0, At, B0); PG8_BAR; PG8_SCHED;
            PG8_LDB(B1, 1, 1); PG8_STAGE(PG8_SB(1, 0), b3, voffB);
            PG8_BAR; PG8_WAIT_L(0); PG8_MMA(0, 1, At, B1); PG8_BAR;
            PG8_LDA(At, 1, 1); PG8_STAGE(PG8_SA(1, 0), a3, voffA);
            PG8_BAR; PG8_WAIT_L(0); PG8_MMA(1, 0, At, B0); PG8_BAR; PG8_SCHED;
            PG8_STAGE(PG8_SB(1, 1), b3 + hstep, voffB);
            PG8_WAIT_V(6); PG8_BAR; PG8_MMA(1, 1, At, B1); PG8_BAR;
            }
        }
        if constexpr (ALIGN_EPI) { if (wr == 0) PG8_BAR; }
        if constexpr (!Epi::AFTER_DRAIN) { E(acc, cur, wr, wc, fr, fq); S.done(cur); }
        if (!has_next) break;
#pragma unroll
        for (int a = 0; a < 2; ++a)
#pragma unroll
            for (int b = 0; b < 2; ++b)
#pragma unroll
                for (int m = 0; m < 4; ++m)
#pragma unroll
                    for (int n = 0; n < 2; ++n) acc[a][b][m][n] = (f32x4){0.f, 0.f, 0.f, 0.f};
        cur = nxt; cA = nA; cB = nB; ++ui;
        if constexpr (ALIGN_EPI) { if (wr == 1) PG8_BAR; }
    }
    PG8_WAIT_V(0);
    if constexpr (!ALIGN_EPI) { if (wr == 0) PG8_BAR; }
    PG8_BAR;
    if constexpr (Epi::AFTER_DRAIN) { E.fused(acc, cur, wr, wc, fr, fq, lds, wid, lane); S.done(cur); }
#undef PG8_SA
#undef PG8_SB
#undef PG8_STAGE
#undef PG8_LDA
#undef PG8_LDB
#undef PG8_MMA
#undef PG8_WAIT_V
#undef PG8_WAIT_L
#undef PG8_BAR
#undef PG8_SCHED
}
}
#define LAS __attribute__((address_space(3)))
using pg8::bf16_t; using pg8::bf16x8; using pg8::f32x4; using pg8::u32x4; using pg8::cvt_pk_bf16; using pg8::bf_lo; using pg8::bf_hi; using pg8::sigmoidf_; using pg8::siluf_;
typedef unsigned u32x2 __attribute__((ext_vector_type(2)));
constexpr int NWAVES = 8, NTHR = 512;
constexpr int MP = 32768, MS = 2048, M = MP + MS, D = 2048, FF = 5632, DIN = 5632, PLE = 256;
constexpr int ZQ = 0, ZK = 1024, ZV = 1280, ZHQ = 1536, ZHF = 2560, ZHI = 3584, ZHG = 4608;
constexpr float EPS = 1e-6f;
constexpr size_t MiB = 1u << 20;
constexpr size_t WS_CTL = 0, CTL_BYTES = 65536;
constexpr size_t WS_W1GU = 1 * MiB, WS_W1D = WS_W1GU + 44 * MiB, WS_WIN = WS_W1D + 22 * MiB, WS_WOUT = WS_WIN + 22 * MiB, WS_W2GU = WS_WOUT + 8 * MiB, WS_W2D = WS_W2GU + 44 * MiB,
                 WS_WPG = WS_W2D + 22 * MiB, WS_WPP = WS_WPG + 8 * MiB, WS_BTAB = WS_WPP + 1 * MiB;
constexpr size_t WS_XN = WS_BTAB + 1 * MiB;
constexpr size_t WS_H = WS_XN + 136 * MiB;
constexpr size_t WS_Y = WS_H + 374 * MiB;
constexpr size_t REC_STRIDE = 27136, NREC = (size_t)(M / 32) * 8;
constexpr size_t WS_U = WS_Y + 136 * MiB;
constexpr size_t WS_PART = WS_U + 136 * MiB;
constexpr size_t WS_PB = 1007 * MiB;
constexpr size_t WS_END = WS_PB + 17 * MiB;
static_assert(WS_PART + 32 * MiB <= WS_PB && WS_U + 136 * MiB <= WS_PB && WS_Y + 228 * MiB <= WS_PB, "ws map 2");
static_assert(NREC * REC_STRIDE + 1024 <= 228 * MiB && WS_END <= 1024 * MiB, "ws map");
constexpr int R_QD = 0, R_KE = 8192, R_IT = 16384, R_A = 24576, R_DEC = 26624;
constexpr size_t O_KP = (size_t)M * D, O_VP = O_KP + 131072, O_SP = O_VP + 131072, O_KS = O_SP + 524288, O_VS = O_KS + 1048576, O_SS = O_VS + 1048576, O_END = O_SS + 4194304;
constexpr int LDS_BYTES = 147456;
constexpr int CW_QUEUE = 0, CW_BAR = 1024;

struct Args { const float* in[29]; float* out; unsigned char* ws; int lo, hi; };
enum { I_XP = 0, I_XS, I_CK, I_CV, I_ST, I_PP, I_PS, I_TAB, I_F1PRE, I_F1POST, I_F1G, I_F1U, I_F1D, I_MPRE, I_MPOST, I_WIN, I_WOUT, I_SINK, I_LB, I_HN, I_F2PRE, I_F2POST, I_F2G, I_F2U, I_F2D, I_PPRE, I_PPOST, I_WPG, I_WPP };

__device__ __forceinline__ float wave_sum(float v) {
#pragma unroll
    for (int o = 1; o < 64; o <<= 1) v += __shfl_xor(v, o);
    return v;
}
#define LDS_WAIT() asm volatile("s_waitcnt lgkmcnt(0)" ::: "memory")

__device__ __forceinline__ void transpose_item(const float* W, int K, int N, bf16_t* WT, int k0, int n0, int drow0, LAS float* scr, int lane) {
    asm volatile("" : "+v"(lane)); __builtin_assume(lane >= 0 && lane < 64);
#pragma unroll 8
    for (int i = 0; i < 32; ++i) { const int kk = 2 * i + (lane >> 5); scr[kk * 33 + (lane & 31)] = __builtin_nontemporal_load(&W[(size_t)(k0 + kk) * N + n0 + (lane & 31)]); }
    LDS_WAIT();
    const int c = lane & 7;
#pragma unroll
    for (int j = 0; j < 4; ++j) { const int n = (lane >> 3) + 8 * j; const LAS float* s = scr + (8 * c) * 33 + n;
        u32x4 o; o.x = cvt_pk_bf16(s[0 * 33], s[1 * 33]); o.y = cvt_pk_bf16(s[2 * 33], s[3 * 33]); o.z = cvt_pk_bf16(s[4 * 33], s[5 * 33]); o.w = cvt_pk_bf16(s[6 * 33], s[7 * 33]);
        *(u32x4*)(WT + (size_t)(drow0 + n) * K + k0 + 8 * c) = o; }
    LDS_WAIT();
}
__device__ __forceinline__ bool transpose_mat(int& r, const float* W, int K, int N, bf16_t* WT, int mode, LAS float* scr, int lane) {
    const int nblk = N / 32, items = (K / 64) * nblk;
    if (r >= items) { r -= items; return false; }
    const int kb = r / nblk, nb = r % nblk, n0 = 32 * nb;
    const int drow0 = mode == 0 ? n0 : (n0 / 128) * 256 + (n0 % 128) + (mode == 2 ? 128 : 0);
    transpose_item(W, K, N, WT, 64 * kb, n0, drow0, scr, lane);
    return true;
}
__device__ __forceinline__ void rms_row_to_bf16(const f32x4 (&v)[8], const float* gain, bf16_t* orow, int lane) {
    const f32x4* gr = (const f32x4*)gain + lane;
    float s = 0.f;
#pragma unroll
    for (int j = 0; j < 8; ++j) s += (v[j].x * v[j].x + v[j].y * v[j].y) + (v[j].z * v[j].z + v[j].w * v[j].w);
    const float rstd = rsqrtf(wave_sum(s) * (1.f / D) + EPS);
    u32x2* o8 = (u32x2*)orow + lane;
#pragma unroll
    for (int j = 0; j < 8; ++j) { const f32x4 g = gr[64 * j]; u32x2 w; w.x = cvt_pk_bf16(v[j].x * rstd * g.x, v[j].y * rstd * g.y); w.y = cvt_pk_bf16(v[j].z * rstd * g.z, v[j].w * rstd * g.w); o8[64 * j] = w; }
}
__device__ __forceinline__ void norm_load_y(const bf16_t* Y, const float* PART, int m, int lane, u32x2 (&y)[8]) {
    const u32x2* yr = (const u32x2*)(Y + (size_t)m * D) + lane;
#pragma unroll
    for (int j = 0; j < 8; ++j) y[j] = __builtin_nontemporal_load(&yr[64 * j]);
    const int pm = m >> 8, q = pm - 16;
    if (PART && q >= 0 && (q & 15) < 8) {
        const int pn = q >> 4, c = (q & 15) * 8 + pn;
        const float* pa = PART + ((size_t)(2 * c) * 256 + (m & 255)) * 256 + 4 * lane;
        const f32x4 a = *(const f32x4*)pa, b = *(const f32x4*)(pa + 65536);
        u32x2 w; w.x = cvt_pk_bf16(a.x + b.x, a.y + b.y); w.y = cvt_pk_bf16(a.z + b.z, a.w + b.w);
#pragma unroll
        for (int j = 0; j < 8; ++j) if (j == pn) y[j] = w;
    }
}
template <bool XIN_BF, bool XOUT_BF>
__device__ __forceinline__ void norm_load_x(const float* xp, const float* xs, const bf16_t* xb, int m, int lane, f32x4 (&v)[8]) {
    if (XIN_BF) { const u32x2* xr = (const u32x2*)(xb + (size_t)m * D) + lane;
#pragma unroll
        for (int j = 0; j < 8; ++j) { const u32x2 w = __builtin_nontemporal_load(&xr[64 * j]); v[j] = (f32x4){bf_lo(w.x), bf_hi(w.x), bf_lo(w.y), bf_hi(w.y)}; }
    } else { const float* xrow = (m < MP) ? xp + (size_t)m * D : xs + (size_t)(m - MP) * D; const f32x4* xr = (const f32x4*)xrow + lane;
#pragma unroll
        for (int j = 0; j < 8; ++j) v[j] = __builtin_nontemporal_load(&xr[64 * j]); }
}
template <bool XIN_BF, bool XOUT_BF>
__device__ __forceinline__ void norm_pass(const float* xp, const float* xs, const bf16_t* xbin, const bf16_t* Y, const float* post, float scale, const float* pre, float* X, bf16_t* xbout, bf16_t* XN, int gw, int NGW, int lane, const float* PART = nullptr) {
    f32x4 v[8]; u32x2 y[8];
    norm_load_x<XIN_BF, XOUT_BF>(xp, xs, xbin, gw, lane, v); norm_load_y(Y, PART, gw, lane, y);
    for (int m = gw; m < M; m += NGW) {
        f32x4 vn[8]; u32x2 yn[8];
        const int mn = m + NGW < M ? m + NGW : m;
        norm_load_x<XIN_BF, XOUT_BF>(xp, xs, xbin, mn, lane, vn); norm_load_y(Y, PART, mn, lane, yn);
        float s = 0.f;
#pragma unroll
        for (int j = 0; j < 8; ++j) { const float a = bf_lo(y[j].x), b = bf_hi(y[j].x), c = bf_lo(y[j].y), d = bf_hi(y[j].y); s += (a * a + b * b) + (c * c + d * d); }
        const float rs = rsqrtf(wave_sum(s) * (1.f / D) + EPS) * scale; float s2 = 0.f;
#pragma unroll
        for (int j = 0; j < 8; ++j) { const f32x4 g = ((const f32x4*)post + lane)[64 * j];
            v[j].x += bf_lo(y[j].x) * rs * g.x; v[j].y += bf_hi(y[j].x) * rs * g.y; v[j].z += bf_lo(y[j].y) * rs * g.z; v[j].w += bf_hi(y[j].y) * rs * g.w;
            s2 += (v[j].x * v[j].x + v[j].y * v[j].y) + (v[j].z * v[j].z + v[j].w * v[j].w);
            if (XOUT_BF) { u32x2 w; w.x = cvt_pk_bf16(v[j].x, v[j].y); w.y = cvt_pk_bf16(v[j].z, v[j].w); __builtin_nontemporal_store(w, &((u32x2*)(xbout + (size_t)m * D) + lane)[64 * j]); }
            else __builtin_nontemporal_store(v[j], &((f32x4*)(X + (size_t)m * D) + lane)[64 * j]); }
        if (pre) {
            const float r2 = rsqrtf(wave_sum(s2) * (1.f / D) + EPS); u32x2* o8 = (u32x2*)(XN + (size_t)m * D) + lane;
#pragma unroll
            for (int j = 0; j < 8; ++j) { const f32x4 g = ((const f32x4*)pre + lane)[64 * j]; u32x2 w; w.x = cvt_pk_bf16(v[j].x * r2 * g.x, v[j].y * r2 * g.y); w.y = cvt_pk_bf16(v[j].z * r2 * g.z, v[j].w * r2 * g.w); o8[64 * j] = w; }
        }
#pragma unroll
        for (int j = 0; j < 8; ++j) { v[j] = vn[j]; y[j] = yn[j]; }
    }
}
constexpr int PREP_WSTRIDE = 2 * 32 * 132 * 2;
typedef short bf16x4 __attribute__((ext_vector_type(4)));
__device__ __forceinline__ void hgrn_prep_item(const bf16_t* Z, const float* lbl, unsigned char* REC, int cidx, int h, LAS unsigned char* wl, int lane) {
    asm volatile("" : "+v"(lane)); __builtin_assume(lane >= 0 && lane < 64);
    LAS bf16_t* Xs = (LAS bf16_t*)wl; LAS bf16_t* Ys = Xs + 32 * 132;
    const int k0 = 2 * lane, m0 = cidx * 32, c16 = lane & 15, g = lane >> 4;
    float lb[2], omlb[2], cum[2] = {0.f, 0.f};
#pragma unroll
    for (int e = 0; e < 2; ++e) { const float l0 = lbl[h * 128 + k0 + e], l1 = lbl[1024 + h * 128 + k0 + e]; lb[e] = __builtin_amdgcn_rcpf(1.f + __expf(l1 - l0)); omlb[e] = 1.f - lb[e]; }
    float cv[32][2]; unsigned omp[32], qraw[32], itp[2][16];
    const bf16_t* zr = Z + (size_t)m0 * DIN + h * 128 + k0;
#pragma unroll
    for (int t = 0; t < 32; ++t) {
        const unsigned ff = *(const unsigned*)(zr + (size_t)t * DIN + ZHF), ii = *(const unsigned*)(zr + (size_t)t * DIN + ZHI);
        qraw[t] = *(const unsigned*)(zr + (size_t)t * DIN + ZHQ); float omv[2];
#pragma unroll
        for (int e = 0; e < 2; ++e) {
            const float fl = e ? bf_hi(ff) : bf_lo(ff);
            const float ex = __expf(-fl), sg = __builtin_amdgcn_rcpf(1.f + ex);
            const float f = lb[e] + omlb[e] * sg;
            omv[e] = omlb[e] * (ex * sg);
            cum[e] += __logf(f); cv[t][e] = cum[e];
        }
        omp[t] = cvt_pk_bf16(omv[0], omv[1]);
        if ((t & 1) == 0) { itp[0][t >> 1] = ii & 0xffffu; itp[1][t >> 1] = ii >> 16; }
        else { itp[0][t >> 1] |= ii << 16; itp[1][t >> 1] |= ii & 0xffff0000u; }
        if ((t & 15) == 15) asm volatile("" ::: "memory");
    }
    unsigned char* R = REC + ((size_t)cidx * 8 + h) * REC_STRIDE;
    {   u32x4* it = (u32x4*)(R + R_IT + k0 * 64);
#pragma unroll
        for (int e = 0; e < 2; ++e)
#pragma unroll
            for (int q4 = 0; q4 < 4; ++q4) it[4 * e + q4] = (u32x4){itp[e][4 * q4], itp[e][4 * q4 + 1], itp[e][4 * q4 + 2], itp[e][4 * q4 + 3]}; }
    const float ref0 = cv[15][0], ref1 = cv[15][1];
    const float eref0 = __expf(ref0), eref1 = __expf(ref1), eL0 = __expf(cum[0] - ref0), eL1 = __expf(cum[1] - ref1);
#pragma unroll
    for (int t = 0; t < 32; ++t) { cv[t][0] = __expf(cv[t][0] - ref0); cv[t][1] = __expf(cv[t][1] - ref1); }
    float ri[32][2];
#pragma unroll
    for (int t = 0; t < 32; ++t) { ri[t][0] = __builtin_amdgcn_rcpf(cv[t][0]); ri[t][1] = __builtin_amdgcn_rcpf(cv[t][1]); }
#pragma unroll
    for (int t = 0; t < 32; ++t) {
        const float q0 = bf_lo(qraw[t]), q1 = bf_hi(qraw[t]);
        *(LAS unsigned*)(Xs + t * 132 + k0) = cvt_pk_bf16(q0 * cv[t][0] * eref0, q1 * cv[t][1] * eref1);
        *(LAS unsigned*)(Ys + t * 132 + k0) = cvt_pk_bf16(bf_lo(omp[t]) * ri[t][0], bf_hi(omp[t]) * ri[t][1]);
    }
    {
        u32x4* ke = (u32x4*)(R + R_KE + k0 * 64);
#pragma unroll
        for (int e = 0; e < 2; ++e) {
            unsigned kep[16];
#pragma unroll
            for (int t2 = 0; t2 < 16; ++t2) kep[t2] = cvt_pk_bf16((e ? bf_hi(omp[2 * t2]) : bf_lo(omp[2 * t2])) * ((e ? eL1 : eL0) * ri[2 * t2][e]), (e ? bf_hi(omp[2 * t2 + 1]) : bf_lo(omp[2 * t2 + 1])) * ((e ? eL1 : eL0) * ri[2 * t2 + 1][e]));
#pragma unroll
            for (int q4 = 0; q4 < 4; ++q4) { ke[4 * e + q4] = (u32x4){kep[4 * q4], kep[4 * q4 + 1], kep[4 * q4 + 2], kep[4 * q4 + 3]}; }
        }
        float2 dd; dd.x = __expf(cum[0]); dd.y = __expf(cum[1]); *(float2*)(R + R_DEC + k0 * 4) = dd;
    }
    LDS_WAIT();
#pragma unroll
    for (int tb = 0; tb < 2; ++tb)
#pragma unroll
        for (int kk = 0; kk < 4; ++kk) {
            const u32x2 lo = *(const LAS u32x2*)(Xs + (16 * tb + c16) * 132 + 32 * kk + 4 * g), hi = *(const LAS u32x2*)(Xs + (16 * tb + c16) * 132 + 32 * kk + 16 + 4 * g);
            *(u32x4*)(R + R_QD + ((tb * 4 + kk) * 64 + lane) * 16) = (u32x4){lo.x, lo.y, hi.x, hi.y};
        }
    LDS_WAIT();
#pragma unroll
    for (int t = 0; t < 32; ++t) {
        const float q0 = bf_lo(qraw[t]), q1 = bf_hi(qraw[t]);
        *(LAS unsigned*)(Xs + t * 132 + k0) = cvt_pk_bf16(q0 * cv[t][0], q1 * cv[t][1]);
    }
    LDS_WAIT();
    f32x4 a00 = {0.f, 0.f, 0.f, 0.f}, a10 = a00, a11 = a00;
#pragma unroll
    for (int kk = 0; kk < 4; ++kk) {
        bf16x8 qf[2], kf[2];
#pragma unroll
        for (int b = 0; b < 2; ++b) {
            const u32x2 qlo = *(const LAS u32x2*)(Xs + (16 * b + c16) * 132 + 32 * kk + 4 * g), qhi = *(const LAS u32x2*)(Xs + (16 * b + c16) * 132 + 32 * kk + 16 + 4 * g);
            const u32x2 klo = *(const LAS u32x2*)(Ys + (16 * b + c16) * 132 + 32 * kk + 4 * g), khi = *(const LAS u32x2*)(Ys + (16 * b + c16) * 132 + 32 * kk + 16 + 4 * g);
            qf[b] = __builtin_bit_cast(bf16x8, ((u32x4){qlo.x, qlo.y, qhi.x, qhi.y})); kf[b] = __builtin_bit_cast(bf16x8, ((u32x4){klo.x, klo.y, khi.x, khi.y}));
        }
        a00 = __builtin_amdgcn_mfma_f32_16x16x32_bf16(kf[0], qf[0], a00, 0, 0, 0);
        a10 = __builtin_amdgcn_mfma_f32_16x16x32_bf16(kf[0], qf[1], a10, 0, 0, 0);
        a11 = __builtin_amdgcn_mfma_f32_16x16x32_bf16(kf[1], qf[1], a11, 0, 0, 0);
    }
#pragma unroll
    for (int i = 0; i < 4; ++i) if (4 * g + i > c16) { a00[i] = 0.f; a11[i] = 0.f; }
    u32x2 w;
    w.x = cvt_pk_bf16(a00[0], a00[1]); w.y = cvt_pk_bf16(a00[2], a00[3]); *(u32x2*)(R + R_A + (c16 * 32 + 4 * g) * 2) = w;
    w.x = 0u; w.y = 0u; *(u32x2*)(R + R_A + (c16 * 32 + 16 + 4 * g) * 2) = w;
    w.x = cvt_pk_bf16(a10[0], a10[1]); w.y = cvt_pk_bf16(a10[2], a10[3]); *(u32x2*)(R + R_A + ((16 + c16) * 32 + 4 * g) * 2) = w;
    w.x = cvt_pk_bf16(a11[0], a11[1]); w.y = cvt_pk_bf16(a11[2], a11[3]); *(u32x2*)(R + R_A + ((16 + c16) * 32 + 16 + 4 * g) * 2) = w;
    LDS_WAIT();
}

constexpr int CH_NS = 4, CH_SLOT = 27648;
static_assert(CH_NS * CH_SLOT <= 131072, "chain LDS");
#define CH_RAWBAR() do { asm volatile("s_waitcnt lgkmcnt(0)" ::: "memory"); __builtin_amdgcn_s_barrier(); asm volatile("" ::: "memory"); } while (0)
__device__ __forceinline__ void ch_issue(const unsigned char* Rl, LAS unsigned char* dst, int wave) {
    __builtin_amdgcn_global_load_lds((const unsigned*)(Rl + wave * 1024), (LAS unsigned*)(dst + wave * 1024), 16, 0, 0);
    __builtin_amdgcn_global_load_lds((const unsigned*)(Rl + (wave + 8) * 1024), (LAS unsigned*)(dst + (wave + 8) * 1024), 16, 0, 0);
    __builtin_amdgcn_global_load_lds((const unsigned*)(Rl + (wave + 16) * 1024), (LAS unsigned*)(dst + (wave + 16) * 1024), 16, 0, 0);
    if (wave < 3) __builtin_amdgcn_global_load_lds((const unsigned*)(Rl + (wave + 24) * 1024), (LAS unsigned*)(dst + (wave + 24) * 1024), 16, 0, 0);
}
#define CH_WAITN(N) asm volatile("s_waitcnt vmcnt(%0)" :: "n"(N) : "memory")
#define CH_WAIT(EX) do { if (wave < 3) CH_WAITN(8 + (EX)); else if (wave == 3) CH_WAITN(6 + (EX)); else CH_WAITN(6); } while (0)
__device__ __forceinline__ void hgrn_chain(const unsigned char* REC, const float* s0, float* sout, bf16_t* MIX,
                                           int cidx0, int nchunks, int h, int vhalf, LAS unsigned char* lds, int wave, int lane) {
    asm volatile("" : "+v"(lane)); __builtin_assume(lane >= 0 && lane < 64);
    const int c16 = lane & 15, g = lane >> 4, v0 = 64 * vhalf + 16 * (wave & 3);
    const bool comp = wave < 4;
    f32x4 S[8];
#pragma unroll
    for (int kb = 0; kb < 8; ++kb)
#pragma unroll
        for (int i = 0; i < 4; ++i) S[kb][i] = (s0 && comp) ? s0[(size_t)(16 * kb + 4 * g + i) * 128 + v0 + c16] : 0.f;
    bf16_t* mo = MIX + (size_t)(cidx0 * 32 + c16) * D + 1024 + h * 128 + v0 + 4 * g;
    const unsigned char* Rl = REC + ((size_t)cidx0 * 8 + h) * REC_STRIDE + lane * 16;
    const unsigned char* Rlast = Rl + (size_t)(nchunks - 1) * 8 * REC_STRIDE;
    asm volatile("s_waitcnt vmcnt(0)" ::: "memory");
    const unsigned char* Ri = Rl;
#pragma unroll
    for (int cc = 0; cc < CH_NS - 1; ++cc) { ch_issue(Ri, lds + cc * CH_SLOT, wave); Ri = Ri < Rlast ? Ri + 8 * REC_STRIDE : Rlast; }
    CH_WAIT(0);
    CH_RAWBAR();
    int slot = 0, islot = CH_NS - 1;
    for (int c = 0; c < nchunks; ++c) {
        ch_issue(Ri, lds + islot * CH_SLOT, wave); Ri = Ri < Rlast ? Ri + 8 * REC_STRIDE : Rlast;
        islot = islot == CH_NS - 1 ? 0 : islot + 1;
        const LAS unsigned char* R = lds + slot * CH_SLOT;
        slot = slot == CH_NS - 1 ? 0 : slot + 1;
        if (comp) {
            bf16x8 QDf[2][4], KEf[8], ITf, Af[2]; f32x4 DEC[8];
#pragma unroll
            for (int kb = 0; kb < 8; ++kb) { DEC[kb] = *(const LAS f32x4*)(R + R_DEC + (16 * kb + 4 * g) * 4); KEf[kb] = *(const LAS bf16x8*)(R + R_KE + ((16 * kb + c16) * 32 + 8 * g) * 2); }
            ITf = *(const LAS bf16x8*)(R + R_IT + ((v0 + c16) * 32 + 8 * g) * 2);
#pragma unroll
            for (int tb = 0; tb < 2; ++tb) {
                Af[tb] = *(const LAS bf16x8*)(R + R_A + ((16 * tb + c16) * 32 + 8 * g) * 2);
#pragma unroll
                for (int kk = 0; kk < 4; ++kk) QDf[tb][kk] = *(const LAS bf16x8*)(R + R_QD + ((tb * 4 + kk) * 64 + lane) * 16);
            }
            bf16x8 Sb[4];
#pragma unroll
            for (int kk = 0; kk < 4; ++kk) {
                u32x4 sb; sb.x = cvt_pk_bf16(S[2 * kk][0], S[2 * kk][1]); sb.y = cvt_pk_bf16(S[2 * kk][2], S[2 * kk][3]);
                sb.z = cvt_pk_bf16(S[2 * kk + 1][0], S[2 * kk + 1][1]); sb.w = cvt_pk_bf16(S[2 * kk + 1][2], S[2 * kk + 1][3]);
                Sb[kk] = __builtin_bit_cast(bf16x8, sb);
            }
#pragma unroll
            for (int kb = 0; kb < 8; ++kb) S[kb] = __builtin_amdgcn_mfma_f32_16x16x32_bf16(KEf[kb], ITf, S[kb] * DEC[kb], 0, 0, 0);
            f32x4 o0 = {0.f, 0.f, 0.f, 0.f}, o1 = o0;
            o0 = __builtin_amdgcn_mfma_f32_16x16x32_bf16(ITf, Af[0], o0, 0, 0, 0);
            o1 = __builtin_amdgcn_mfma_f32_16x16x32_bf16(ITf, Af[1], o1, 0, 0, 0);
#pragma unroll
            for (int kk = 0; kk < 4; ++kk) { o0 = __builtin_amdgcn_mfma_f32_16x16x32_bf16(Sb[kk], QDf[0][kk], o0, 0, 0, 0); o1 = __builtin_amdgcn_mfma_f32_16x16x32_bf16(Sb[kk], QDf[1][kk], o1, 0, 0, 0); }
            u32x2 w; w.x = cvt_pk_bf16(o0[0], o0[1]); w.y = cvt_pk_bf16(o0[2], o0[3]);
            *(u32x2*)(mo + (size_t)c * 32 * D) = w;
            w.x = cvt_pk_bf16(o1[0], o1[1]); w.y = cvt_pk_bf16(o1[2], o1[3]);
            *(u32x2*)(mo + (size_t)c * 32 * D + (size_t)16 * D) = w;
        }
        if (c == 0) CH_WAIT(2); else if (c == 1) CH_WAIT(4); else CH_WAIT(6);
        CH_RAWBAR();
    }
    if (comp) {
#pragma unroll
        for (int kb = 0; kb < 8; ++kb)
#pragma unroll
            for (int i = 0; i < 4; ++i) sout[(size_t)(16 * kb + 4 * g + i) * 128 + v0 + c16] = S[kb][i];
    }
    asm volatile("s_waitcnt vmcnt(0)" ::: "memory");
    CH_RAWBAR();
}
__device__ __forceinline__ void rec_norm_pass(const bf16_t* Z, const float* gain, bf16_t* MIX, int gw, int NGW, int lane) {
    const int part = lane & 15;
    const f32x4 g0 = *(const f32x4*)(gain + 8 * part), g1 = *(const f32x4*)(gain + 8 * part + 4);
    const int p0 = gw * 4 + (lane >> 4), NP = M * 8, step = NGW * 4;
    u32x4 ov, gv;
    { const int m = p0 >> 3, h = p0 & 7; ov = *(const u32x4*)(MIX + (size_t)m * D + 1024 + h * 128 + 8 * part); gv = __builtin_nontemporal_load((const u32x4*)(Z + (size_t)m * DIN + ZHG + h * 128 + 8 * part)); }
    for (int p = p0; p < NP; p += step) {
        const int m = p >> 3, h = p & 7, pn = p + step < NP ? p + step : p, mn = pn >> 3, hn = pn & 7;
        bf16_t* op = MIX + (size_t)m * D + 1024 + h * 128 + 8 * part;
        const u32x4 ovn = *(const u32x4*)(MIX + (size_t)mn * D + 1024 + hn * 128 + 8 * part), gvn = __builtin_nontemporal_load((const u32x4*)(Z + (size_t)mn * DIN + ZHG + hn * 128 + 8 * part));
        float x[8] = {bf_lo(ov.x), bf_hi(ov.x), bf_lo(ov.y), bf_hi(ov.y), bf_lo(ov.z), bf_hi(ov.z), bf_lo(ov.w), bf_hi(ov.w)};
        float s = 0.f;
#pragma unroll
        for (int j = 0; j < 8; ++j) s += x[j] * x[j];
        s += __shfl_xor(s, 1); s += __shfl_xor(s, 2); s += __shfl_xor(s, 4); s += __shfl_xor(s, 8);
        const float rs = rsqrtf(s * (1.f / 128.f) + EPS);
        u32x4 w;
        w.x = cvt_pk_bf16(x[0] * rs * g0.x * siluf_(bf_lo(gv.x)), x[1] * rs * g0.y * siluf_(bf_hi(gv.x)));
        w.y = cvt_pk_bf16(x[2] * rs * g0.z * siluf_(bf_lo(gv.y)), x[3] * rs * g0.w * siluf_(bf_hi(gv.y)));
        w.z = cvt_pk_bf16(x[4] * rs * g1.x * siluf_(bf_lo(gv.z)), x[5] * rs * g1.y * siluf_(bf_hi(gv.z)));
        w.w = cvt_pk_bf16(x[6] * rs * g1.z * siluf_(bf_lo(gv.w)), x[7] * rs * g1.w * siluf_(bf_hi(gv.w)));
        *(u32x4*)op = w;
        ov = ovn; gv = gvn;
    }
}
constexpr int KS_STRIDE = 136, VT_STRIDE = 196;
constexpr int ATT_KS = 0, ATT_VT = 192 * KS_STRIDE * 2, ATT_BT = ATT_VT + 128 * VT_STRIDE * 2, ATT_END = ATT_BT + 4 * 256 * 4;
static_assert(ATT_END <= 131072, "attention LDS");
__device__ __forceinline__ void attn_item(const bf16_t* Z, const float* ck, const float* cv, const float* btab, const float* sinks, bf16_t* MIX, int item, LAS unsigned char* lds, int tid, int wave, int lane) {
    asm volatile("" : "+v"(tid), "+v"(lane)); __builtin_assume(lane >= 0 && lane < 64 && tid >= 0 && tid < 512);
    LAS bf16_t* Ks = (LAS bf16_t*)(lds + ATT_KS); LAS bf16_t* VTs = (LAS bf16_t*)(lds + ATT_VT); LAS float* bts = (LAS float*)(lds + ATT_BT);
    const bool prompt = item < 1024;
    int kvh, qrow0, krow0, kmin, sidx = 0;
    if (prompt) { const int b = item >> 8, c = (item >> 1) & 127; kvh = item & 1; qrow0 = b * 8192 + c * 64; krow0 = qrow0 - 128; kmin = c == 0 ? 128 : (c == 1 ? 64 : 0); }
    else { sidx = (item - 1024) >> 1; kvh = item & 1; qrow0 = MP + sidx * 64; krow0 = qrow0 - 128; kmin = 0; }
#pragma unroll 2
    for (int it = 0; it < 6; ++it) {
        const int task = tid + NTHR * it, kq = task & 3, key = (task >> 2) % 192, ch = (task / 768) * 4 + kq;
        u32x4 kv4 = {0u, 0u, 0u, 0u}, vv4 = {0u, 0u, 0u, 0u};
        if (!prompt && key < 128) {
            const float* kp = ck + ((size_t)(sidx * 128 + key) * 2 + kvh) * 128 + ch * 8; const float* vp = cv + ((size_t)(sidx * 128 + key) * 2 + kvh) * 128 + ch * 8;
            const f32x4 a = *(const f32x4*)kp, b = *(const f32x4*)(kp + 4), c = *(const f32x4*)vp, d = *(const f32x4*)(vp + 4);
            kv4 = (u32x4){cvt_pk_bf16(a.x, a.y), cvt_pk_bf16(a.z, a.w), cvt_pk_bf16(b.x, b.y), cvt_pk_bf16(b.z, b.w)};
            vv4 = (u32x4){cvt_pk_bf16(c.x, c.y), cvt_pk_bf16(c.z, c.w), cvt_pk_bf16(d.x, d.y), cvt_pk_bf16(d.z, d.w)};
        } else if (key >= kmin) {
            const bf16_t* zp = Z + (size_t)(krow0 + key) * DIN + ZK + kvh * 128 + ch * 8;
            kv4 = *(const u32x4*)zp; vv4 = *(const u32x4*)(zp + 256);
        }
        *(LAS u32x4*)(Ks + key * KS_STRIDE + ch * 8) = kv4;
        LAS bf16_t* vt = VTs + (ch * 8) * VT_STRIDE + key;
        vt[0 * VT_STRIDE] = (bf16_t)(vv4.x & 0xffffu); vt[1 * VT_STRIDE] = (bf16_t)(vv4.x >> 16); vt[2 * VT_STRIDE] = (bf16_t)(vv4.y & 0xffffu); vt[3 * VT_STRIDE] = (bf16_t)(vv4.y >> 16);
        vt[4 * VT_STRIDE] = (bf16_t)(vv4.z & 0xffffu); vt[5 * VT_STRIDE] = (bf16_t)(vv4.z >> 16); vt[6 * VT_STRIDE] = (bf16_t)(vv4.w & 0xffffu); vt[7 * VT_STRIDE] = (bf16_t)(vv4.w >> 16);
    }
    for (int i = tid; i < 1024; i += NTHR) bts[i] = btab[(kvh * 4 + (i >> 8)) * 256 + (i & 255)];
    const int c16 = lane & 15, g = lane >> 4, gh = wave >> 1, qhalf = wave & 1, hq = kvh * 4 + gh;
    bf16x8 Qf[2][4];
#pragma unroll
    for (int nb = 0; nb < 2; ++nb)
#pragma unroll
        for (int kk = 0; kk < 4; ++kk) Qf[nb][kk] = *(const bf16x8*)(Z + (size_t)(qrow0 + qhalf * 32 + nb * 16 + c16) * DIN + ZQ + hq * 128 + 32 * kk + 8 * g);
    const float sink = sinks[hq];
    __syncthreads();
    f32x4 sacc[12][2];
#pragma unroll
    for (int mb = 0; mb < 12; ++mb) { sacc[mb][0] = (f32x4){0.f, 0.f, 0.f, 0.f}; sacc[mb][1] = (f32x4){0.f, 0.f, 0.f, 0.f};
#pragma unroll
        for (int kk = 0; kk < 4; ++kk) { const bf16x8 Kf = *(const LAS bf16x8*)(Ks + (16 * mb + c16) * KS_STRIDE + 32 * kk + 8 * g);
            sacc[mb][0] = __builtin_amdgcn_mfma_f32_16x16x32_bf16(Kf, Qf[0][kk], sacc[mb][0], 0, 0, 0);
            sacc[mb][1] = __builtin_amdgcn_mfma_f32_16x16x32_bf16(Kf, Qf[1][kk], sacc[mb][1], 0, 0, 0); } }
    float inv[2];
    const float scale = 0.08838834764831845f;
#pragma unroll
    for (int nb = 0; nb < 2; ++nb) {
        const int qidx = qhalf * 32 + nb * 16 + c16; float mx = -3.0e38f;
#pragma unroll
        for (int mb = 0; mb < 12; ++mb)
#pragma unroll
            for (int i = 0; i < 4; ++i) { const int kidx = 16 * mb + 4 * g + i; float s = sacc[mb][nb][i] * scale + bts[gh * 256 + kidx - qidx + 63]; s = kidx < kmin ? -1e30f : s; sacc[mb][nb][i] = s; mx = fmaxf(mx, s); }
        mx = fmaxf(mx, __shfl_xor(mx, 16)); mx = fmaxf(mx, __shfl_xor(mx, 32)); mx = fmaxf(mx, sink);
        float sum = 0.f;
#pragma unroll
        for (int mb = 0; mb < 12; ++mb)
#pragma unroll
            for (int i = 0; i < 4; ++i) { const float e = __expf(sacc[mb][nb][i] - mx); sum += e; sacc[mb][nb][i] = e; }
        sum += __shfl_xor(sum, 16); sum += __shfl_xor(sum, 32); sum += __expf(sink - mx);
        inv[nb] = 1.0f / sum;
    }
    bf16x8 Pf[2][6];
#pragma unroll
    for (int nb = 0; nb < 2; ++nb)
#pragma unroll
        for (int ks = 0; ks < 6; ++ks) { u32x4 p; p.x = cvt_pk_bf16(sacc[2 * ks][nb][0], sacc[2 * ks][nb][1]); p.y = cvt_pk_bf16(sacc[2 * ks][nb][2], sacc[2 * ks][nb][3]);
            p.z = cvt_pk_bf16(sacc[2 * ks + 1][nb][0], sacc[2 * ks + 1][nb][1]); p.w = cvt_pk_bf16(sacc[2 * ks + 1][nb][2], sacc[2 * ks + 1][nb][3]); Pf[nb][ks] = __builtin_bit_cast(bf16x8, p); }
#pragma unroll
    for (int db = 0; db < 8; ++db) {
        f32x4 o0 = {0.f, 0.f, 0.f, 0.f}, o1 = {0.f, 0.f, 0.f, 0.f};
#pragma unroll
        for (int ks = 0; ks < 6; ++ks) { const LAS bf16_t* vp = VTs + (16 * db + c16) * VT_STRIDE + 32 * ks + 4 * g; const u32x2 lo = *(const LAS u32x2*)vp, hi = *(const LAS u32x2*)(vp + 16);
            const bf16x8 Vf = __builtin_bit_cast(bf16x8, ((u32x4){lo.x, lo.y, hi.x, hi.y}));
            o0 = __builtin_amdgcn_mfma_f32_16x16x32_bf16(Vf, Pf[0][ks], o0, 0, 0, 0);
            o1 = __builtin_amdgcn_mfma_f32_16x16x32_bf16(Vf, Pf[1][ks], o1, 0, 0, 0); }
        o0 = o0 * inv[0]; o1 = o1 * inv[1];
        u32x2 w0, w1; w0.x = cvt_pk_bf16(o0[0], o0[1]); w0.y = cvt_pk_bf16(o0[2], o0[3]); w1.x = cvt_pk_bf16(o1[0], o1[1]); w1.y = cvt_pk_bf16(o1[2], o1[3]);
        *(u32x2*)(MIX + (size_t)(qrow0 + qhalf * 32 + c16) * D + hq * 128 + 16 * db + 4 * g) = w0;
        *(u32x2*)(MIX + (size_t)(qrow0 + qhalf * 32 + 16 + c16) * D + hq * 128 + 16 * db + 4 * g) = w1;
    }
    __syncthreads();
}
#define XB_TMO      128
#define XB_XCNT(j)  (256  + 64 * (j))
#define XB_XSUB(j)  (1280 + 64 * (j))
#define XB_XGEN(j)  (2304 + 64 * (j))
#define XB_TOP      3328
#define XB_TOPGEN   3392
#define XCD_BAR_WORDS 3456
#define XB_SPIN_CAP (1u << 18)

__device__ __forceinline__ unsigned xb_ld(unsigned* p)              { return __hip_atomic_load(p, __ATOMIC_RELAXED, __HIP_MEMORY_SCOPE_AGENT); }
__device__ __forceinline__ unsigned xb_add(unsigned* p, unsigned v) { return __hip_atomic_fetch_add(p, v, __ATOMIC_RELAXED, __HIP_MEMORY_SCOPE_AGENT); }
__device__ __forceinline__ unsigned xb_xcc_id() { return (unsigned)__builtin_amdgcn_s_getreg((3 << 11) | 20) & 0xFu; }
#define XB_SPIN(cond, bar) do { unsigned _sp = 0; while (cond) { __builtin_amdgcn_s_sleep(1); \
    if ((++_sp & 255u) == 0u) { if (xb_ld(&(bar)[XB_TMO])) break; if (_sp > XB_SPIN_CAP) { atomicAdd(&(bar)[XB_TMO], 1u); break; } } } } while (0)

struct XcdBarrier {
    unsigned* bar; unsigned x;
    volatile LAS unsigned* st;
};

__device__ __forceinline__ XcdBarrier xcd_barrier_post(unsigned* bar, volatile LAS unsigned* st) {
    XcdBarrier b; b.bar = bar; b.x = xb_xcc_id(); b.st = st;
    if (threadIdx.x == 0) (void)xb_add(&bar[XB_XCNT(b.x)], 1u);
    return b;
}
__device__ __forceinline__ void xcd_barrier_complete(unsigned* bar, unsigned x, unsigned& nloc, unsigned& nx) {
    const unsigned G = gridDim.x * gridDim.y * gridDim.z;
    unsigned sum, cnt, mine, sp = 0u;
    for (;;) {
        sum = 0u; cnt = 0u; mine = 0u;
#pragma unroll
        for (unsigned j = 0; j < 16; ++j) { const unsigned c = xb_ld(&bar[XB_XCNT(j)]); sum += c; cnt += (c > 0u) ? 1u : 0u; mine = (j == x) ? c : mine; }
        if (sum == G) break;
        __builtin_amdgcn_s_sleep(1);
        if ((++sp & 255u) == 0u) { if (xb_ld(&bar[XB_TMO])) break; if (sp > XB_SPIN_CAP) { atomicAdd(&bar[XB_TMO], 1u); break; } }
    }
    nloc = mine > 0u ? mine : 1u; nx = cnt > 0u ? cnt : 1u;
}

__device__ __forceinline__ void xcd_barrier(const XcdBarrier& b) {
    asm volatile("s_waitcnt vmcnt(0)" ::: "memory");
    __syncthreads();
    if (threadIdx.x == 0) {
        unsigned* bar = b.bar;
        __builtin_amdgcn_s_waitcnt(0);
        unsigned nloc = b.st[0], nx = b.st[1];
        if (nloc == 0u) { xcd_barrier_complete(bar, b.x, nloc, nx); b.st[0] = nloc; b.st[1] = nx; }
        const unsigned old = xb_add(&bar[XB_XSUB(b.x)], 1u);
        const unsigned gen = old / nloc;
        if (old + 1u == (gen + 1u) * nloc) {
            __builtin_amdgcn_fence(__ATOMIC_RELEASE, "agent");
            asm volatile("s_waitcnt vmcnt(0)" ::: "memory");
            const unsigned og = xb_add(&bar[XB_TOP], 1u);
            const unsigned tg = og / nx;
            if (og + 1u == (tg + 1u) * nx) xb_add(&bar[XB_TOPGEN], 1u);
            else XB_SPIN(xb_ld(&bar[XB_TOPGEN]) == tg, bar);
            __builtin_amdgcn_fence(__ATOMIC_ACQUIRE, "agent");
            xb_add(&bar[XB_XGEN(b.x)], 1u);
            asm volatile("s_waitcnt vmcnt(0)" ::: "memory");
        } else {
            XB_SPIN(xb_ld(&bar[XB_XGEN(b.x)]) == gen, bar);
            __builtin_amdgcn_fence(__ATOMIC_ACQUIRE, "agent");
            asm volatile("s_waitcnt vmcnt(0)" ::: "memory");
        }
    }
    __syncthreads();
}

constexpr int NPHASE = 16;
__global__ void __launch_bounds__(NTHR, 2) hybrid_fwd(Args args) {
    extern __shared__ __attribute__((aligned(16))) unsigned char lds_raw[];
    LAS unsigned char* lds = (LAS unsigned char*)lds_raw;
    cg::grid_group grid = cg::this_grid();
    const int tid = threadIdx.x, lane = tid & 63, wave = __builtin_amdgcn_readfirstlane(tid >> 6);
    const int G = gridDim.x, bx = blockIdx.x;
    const int gw = bx * NWAVES + wave, NGW = G * NWAVES;
    unsigned char* ws = args.ws; float* out = args.out;
    unsigned* ctl = (unsigned*)(ws + WS_CTL);
    bf16_t* W1GU = (bf16_t*)(ws + WS_W1GU); bf16_t* W1D = (bf16_t*)(ws + WS_W1D); bf16_t* WIN = (bf16_t*)(ws + WS_WIN); bf16_t* WOUT = (bf16_t*)(ws + WS_WOUT);
    bf16_t* W2GU = (bf16_t*)(ws + WS_W2GU); bf16_t* W2D = (bf16_t*)(ws + WS_W2D); bf16_t* WPG = (bf16_t*)(ws + WS_WPG); bf16_t* WPP = (bf16_t*)(ws + WS_WPP);
    float* BTAB = (float*)(ws + WS_BTAB);
    bf16_t* XN = (bf16_t*)(ws + WS_XN); bf16_t* MIX = XN; bf16_t* H = (bf16_t*)(ws + WS_H); bf16_t* Zb = H; bf16_t* U = (bf16_t*)(ws + WS_U); bf16_t* Y = (bf16_t*)(ws + WS_Y);
    bf16_t* XB0 = (bf16_t*)out; bf16_t* XB1 = (bf16_t*)(ws + WS_H);
    float* PART = (float*)(ws + WS_PART); unsigned char* REC = ws + WS_Y; bf16_t* PB = (bf16_t*)(ws + WS_PB);
    const int lo = args.lo, hi = args.hi;
#define IN(k) (lo <= (k) && (k) < hi)
#define SEAM(k) do { if (IN(k) && IN((k) + 1)) { if ((k) == 0) grid.sync(); else xcd_barrier(xbar); } } while (0)
    {   volatile LAS unsigned* bst = (volatile LAS unsigned*)(lds + 147408);
        if (tid < 2) bst[tid] = 0u;
        __syncthreads(); }
    const XcdBarrier xbar = xcd_barrier_post(ctl + CW_BAR, (volatile LAS unsigned*)(lds + 147408));

    if (IN(0)) {
        LAS float* scr = (LAS float*)(lds + wave * 16384);
        constexpr int IT_BIG = 32 * 176;
        constexpr int NITEMS = 2 * IT_BIG;
        for (int it = gw; it < NITEMS; it += NGW) {
            int r = it;
            if (transpose_mat(r, args.in[I_F1G], D, FF, W1GU, 1, scr, lane)) continue;
            transpose_mat(r, args.in[I_F1U], D, FF, W1GU, 2, scr, lane);
        }
        f32x4 xv[8];
        { const f32x4* xr = (const f32x4*)(args.in[I_XP] + (size_t)gw * D) + lane;
#pragma unroll
          for (int j = 0; j < 8; ++j) xv[j] = __builtin_nontemporal_load(&xr[64 * j]); }
        for (int m = gw; m < M; m += NGW) {
            const int mn = m + NGW < M ? m + NGW : m;
            const float* xrow = (mn < MP) ? args.in[I_XP] + (size_t)mn * D : args.in[I_XS] + (size_t)(mn - MP) * D;
            f32x4 xn[8];
#pragma unroll
            for (int j = 0; j < 8; ++j) xn[j] = __builtin_nontemporal_load(&((const f32x4*)xrow + lane)[64 * j]);
            rms_row_to_bf16(xv, args.in[I_F1PRE], XN + (size_t)m * D, lane);
#pragma unroll
            for (int j = 0; j < 8; ++j) xv[j] = xn[j];
            const float* prow = (m < MP) ? args.in[I_PP] + (size_t)m * PLE : args.in[I_PS] + (size_t)(m - MP) * PLE;
            const f32x4 pv = __builtin_nontemporal_load(&((const f32x4*)prow)[lane]); u32x2 w; w.x = cvt_pk_bf16(pv.x, pv.y); w.y = cvt_pk_bf16(pv.z, pv.w);
            ((u32x2*)(PB + (size_t)m * PLE))[lane] = w;
        }
        if (bx == 0) {
            for (int i = tid; i < 8 * 256; i += NTHR) {
                const int h = i >> 8, idx = i & 255, rel = idx - 191, n = rel < 0 ? -rel : rel;
                const int large = 8 + (n >= 12) + (n >= 16) + (n >= 23) + (n >= 32) + (n >= 46) + (n >= 64) + (n >= 91);
                const int bucket = (rel > 0 ? 16 : 0) + (n < 8 ? n : large);
                BTAB[i] = args.in[I_TAB][bucket * 8 + h];
            }
        }
    }
    SEAM(0);
    if (IN(1)) { { pg8::Gemm g{XN, W1GU, M, 2 * FF, D}; pg8::StaticOrder S; S.init(M, 2 * FF, G, bx); pg8::EpiSwiGLU E{H, FF};
        pg8::gemm_phase<pg8::EpiSwiGLU, pg8::StaticOrder, true, true>(lds, g, S, E); }
        if (bx >= 96) { LAS float* scr = (LAS float*)(lds + wave * 16384); constexpr int IT_BIG = 32 * 176;
            for (int it = (bx - 96) * NWAVES + wave; it < 2 * IT_BIG; it += 160 * NWAVES) { int r = it;
                if (transpose_mat(r, args.in[I_F1D], FF, D, W1D, 0, scr, lane)) continue;
                transpose_mat(r, args.in[I_WIN], D, DIN, WIN, 0, scr, lane); } } }
    SEAM(1);
    if (IN(2)) {
        { pg8::Gemm g{H, W1D, M, D, FF}; pg8::RangeOrder<0, 4> S; S.init(M, D, G, bx); pg8::EpiBf16 E{Y, D};
          pg8::gemm_phase<pg8::EpiBf16, pg8::RangeOrder<0, 4>, true, true>(lds, g, S, E); }
        if (bx < 128) { const int hk = (bx & 1) * (FF / 2);
            pg8::Gemm g{H + hk, W1D + hk, M, D, FF / 2, FF}; pg8::RangeOrder<4, 5> S; S.init(M, D, G, bx >> 1); pg8::EpiF32Tile E{PART + (size_t)bx * 65536};
            pg8::gemm_phase<pg8::EpiF32Tile, pg8::RangeOrder<4, 5>, true, true>(lds, g, S, E); }
        else { LAS float* scr = (LAS float*)(lds + wave * 16384); constexpr int IT_BIG = 32 * 176;
            for (int it = (bx - 128) * NWAVES + wave; it < 2 * IT_BIG; it += 128 * NWAVES) { int r = it;
                if (transpose_mat(r, args.in[I_F2G], D, FF, W2GU, 1, scr, lane)) continue;
                transpose_mat(r, args.in[I_F2U], D, FF, W2GU, 2, scr, lane); } } }
    SEAM(2);
    if (IN(3)) norm_pass<false, true>(args.in[I_XP], args.in[I_XS], nullptr, Y, args.in[I_F1POST], 0.5f, args.in[I_MPRE], nullptr, XB0, XN, gw, NGW, lane, PART);
    SEAM(3);
    if (IN(4)) { { pg8::Gemm g{XN, WIN, M, DIN, D}; pg8::StaticOrder S; S.init(M, DIN, G, bx); pg8::EpiBf16 E{Zb, DIN, true};
        pg8::gemm_phase<pg8::EpiBf16, pg8::StaticOrder, true, true>(lds, g, S, E); }
        if (bx >= 176) { LAS float* scr = (LAS float*)(lds + wave * 16384); constexpr int IT_SQ = 32 * 64, IT_PP = 4 * 64;
            for (int it = (bx - 176) * NWAVES + wave; it < IT_SQ + IT_PP; it += 80 * NWAVES) { int r = it;
                if (transpose_mat(r, args.in[I_WOUT], D, D, WOUT, 0, scr, lane)) continue;
                transpose_mat(r, args.in[I_WPP], PLE, D, WPP, 0, scr, lane); } } }
    SEAM(4);
    if (IN(5)) {
        for (int cidx = bx; cidx < M / 32; cidx += G) hgrn_prep_item(Zb, args.in[I_LB], REC, cidx, wave, lds + wave * PREP_WSTRIDE, lane);
        const int gt = bx * NTHR + tid, NGT = G * NTHR;
        for (int idx = gt; idx < 2 * (131072 + 1048576); idx += NGT) {
            if (idx < 262144) { const int which = idx >> 17, r = idx & 131071, b = r >> 15, j = (r >> 8) & 127, c = r & 255;
                out[O_KP + idx] = __uint_as_float((unsigned)Zb[(size_t)(b * 8192 + 8064 + j) * DIN + ZK + which * 256 + c] << 16); }
            else { const int r2 = idx - 262144, which = r2 >> 20, r = r2 & 1048575, s = r >> 15, j = (r >> 8) & 127, c = r & 255;
                float v;
                if (j < 64) v = args.in[which ? I_CV : I_CK][(size_t)(s * 128 + 64 + j) * 256 + c];
                else v = __uint_as_float((unsigned)Zb[(size_t)(MP + s * 64 + j - 64) * DIN + ZK + which * 256 + c] << 16);
                out[O_KS + r2] = v; }
        }
    }
    SEAM(5);
    if (IN(6)) {
        LAS int* qslot = (LAS int*)(lds + 147392);
        constexpr int N_PCH = 64, N_ATT = 1088, N_SCH = 512, N_ALL = N_PCH + N_ATT + N_SCH;
        for (;;) {
            if (tid == 0) *qslot = (int)atomicAdd(ctl + CW_QUEUE, 1u);
            __syncthreads();
            const int it = *qslot;
            __syncthreads();
            if (it >= N_ALL) break;
            if (it < N_PCH) { const int ch = it >> 1, b = ch >> 3, h = ch & 7;
                hgrn_chain(REC, nullptr, out + O_SP + (size_t)ch * 16384, MIX, b * 256, 256, h, it & 1, lds, wave, lane); }
            else if (it < N_PCH + N_ATT) attn_item(Zb, args.in[I_CK], args.in[I_CV], BTAB, args.in[I_SINK], MIX, it - N_PCH, lds, tid, wave, lane);
            else { const int si = it - N_PCH - N_ATT, sc = si >> 1, s = sc >> 3, h = sc & 7;
                hgrn_chain(REC, args.in[I_ST] + (size_t)sc * 16384, out + O_SS + (size_t)sc * 16384, MIX, 1024 + s * 2, 2, h, si & 1, lds, wave, lane); }
        }
    }
    SEAM(6);
    if (IN(7)) rec_norm_pass(Zb, args.in[I_HN], MIX, gw, NGW, lane);
    SEAM(7);
    if (IN(8)) { { pg8::Gemm g{MIX, WOUT, M, D, D}; pg8::StaticOrder S; S.init(M, D, G, bx); pg8::EpiBf16 E{Y, D};
        pg8::gemm_phase<pg8::EpiBf16, pg8::StaticOrder, true, true>(lds, g, S, E); }
        if (G == 256 ? bx >= 64 : true) { pg8::Gemm g{PB, WPP, M, D, PLE}; pg8::StaticOrder S; if (G == 256) S.init(M, D, 192, bx - 64); else S.init(M, D, G, bx); pg8::EpiBf16 E{U, D};
            pg8::gemm_phase<pg8::EpiBf16, pg8::StaticOrder, true, true>(lds, g, S, E); } }
    SEAM(8);
    if (IN(9)) norm_pass<true, true>(nullptr, nullptr, XB0, Y, args.in[I_MPOST], 1.0f, args.in[I_F2PRE], nullptr, XB0, XN, gw, NGW, lane);
    SEAM(9);
    if (IN(10)) { { pg8::Gemm g{XN, W2GU, M, 2 * FF, D}; pg8::StaticOrder S; S.init(M, 2 * FF, G, bx); pg8::EpiSwiGLU E{H, FF};
        pg8::gemm_phase<pg8::EpiSwiGLU, pg8::StaticOrder, true, true>(lds, g, S, E); }
        if (bx >= 96) { LAS float* scr = (LAS float*)(lds + wave * 16384); constexpr int IT_BIG = 32 * 176, IT_SQ = 32 * 64;
            for (int it = (bx - 96) * NWAVES + wave; it < IT_BIG + IT_SQ; it += 160 * NWAVES) { int r = it;
                if (transpose_mat(r, args.in[I_F2D], FF, D, W2D, 0, scr, lane)) continue;
                transpose_mat(r, args.in[I_WPG], D, D, WPG, 0, scr, lane); } } }
    SEAM(10);
    if (IN(11)) {
        { pg8::Gemm g{H, W2D, M, D, FF}; pg8::RangeOrder<0, 4> S; S.init(M, D, G, bx); pg8::EpiBf16 E{Y, D};
          pg8::gemm_phase<pg8::EpiBf16, pg8::RangeOrder<0, 4>, true, true>(lds, g, S, E); }
        if (bx < 128) { const int hk = (bx & 1) * (FF / 2);
            pg8::Gemm g{H + hk, W2D + hk, M, D, FF / 2, FF}; pg8::RangeOrder<4, 5> S; S.init(M, D, G, bx >> 1); pg8::EpiF32Tile E{PART + (size_t)bx * 65536};
            pg8::gemm_phase<pg8::EpiF32Tile, pg8::RangeOrder<4, 5>, true, true>(lds, g, S, E); } }
    SEAM(11);
    if (IN(12)) norm_pass<true, true>(nullptr, nullptr, XB0, Y, args.in[I_F2POST], 0.5f, args.in[I_PPRE], nullptr, XB1, XN, gw, NGW, lane, PART);
    SEAM(12);
    if (IN(14)) { pg8::Gemm g{XN, WPG, M, D, D}; pg8::StaticOrder S; S.init(M, D, G, bx); pg8::EpiSigMul E{Y, U, D};
        pg8::gemm_phase<pg8::EpiSigMul, pg8::StaticOrder, true, true>(lds, g, S, E); }
    SEAM(14);
    if (IN(15)) norm_pass<true, false>(nullptr, nullptr, XB1, Y, args.in[I_PPOST], 1.0f, nullptr, out, nullptr, nullptr, gw, NGW, lane);
#undef IN
#undef SEAM
}

extern "C" void kernel_launch(void* const* d_in, const int* in_sizes, int n_in, void* d_out, int out_size, void* d_ws, size_t ws_size, hipStream_t stream) {
    static int grid = 0;
    if (grid == 0) {
        if (n_in != 29 || (size_t)out_size != O_END || ws_size < WS_END) { fprintf(stderr, "kernel_launch: unexpected sizes n_in %d out %d ws %zu\n", n_in, out_size, ws_size); grid = -1; return; }
        int dev = 0, cus = 0, per_cu = 0;
        hipGetDevice(&dev); hipDeviceGetAttribute(&cus, hipDeviceAttributeMultiprocessorCount, dev);
        if (hipFuncSetAttribute((const void*)hybrid_fwd, hipFuncAttributeMaxDynamicSharedMemorySize, LDS_BYTES) != hipSuccess) { fprintf(stderr, "kernel_launch: hipFuncSetAttribute failed\n"); grid = -1; return; }
        if (hipOccupancyMaxActiveBlocksPerMultiprocessor(&per_cu, (const void*)hybrid_fwd, NTHR, LDS_BYTES) != hipSuccess || per_cu < 1) per_cu = 1;
        (void)hipGetLastError();
        grid = cus * per_cu;
        if (grid != 256) { fprintf(stderr, "kernel_launch: this build needs a 256-workgroup grid (got %d)\n", grid); grid = -1; return; }
        fprintf(stderr, "kernel_launch: grid %d (cus %d x %d)\n", grid, cus, per_cu);
    }
    if (grid < 0) return;
    hipMemsetAsync((char*)d_ws + WS_CTL, 0, CTL_BYTES, stream);
    Args a{};
    for (int i = 0; i < 29; ++i) a.in[i] = (const float*)d_in[i];
    a.out = (float*)d_out; a.ws = (unsigned char*)d_ws; a.lo = 0; a.hi = NPHASE;
    void* kargs[] = {&a};
    hipError_t e = hipLaunchCooperativeKernel((const void*)hybrid_fwd, dim3(grid), dim3(NTHR), kargs, LDS_BYTES, stream);
    if (e != hipSuccess) fprintf(stderr, "kernel_launch: cooperative launch failed: %s (grid %d)\n", hipGetErrorString(e), grid);
}
```
